# Optimizing an MI355X kernel written in HIP

```python
import math
import jax
import jax.numpy as jnp
from jax import lax
import numpy as np

D_MODEL = 1024
BATCH = 16
SEQ = 2048
DEPTH = 2

CTX_LEN = 256
GRID_W = 64
ROPE_THETA = 10000.0
LN_EPS = 1e-6
RMS_EPS = 1e-5
NEG_INF = -1e30
Q_BLOCK = 128

A_GROUPS = 4
A_GROUP_DIM = 128
A_WIDTH = A_GROUPS * A_GROUP_DIM
CHUNK = 128

B_HEADS = 4
B_HEAD_DIM = 64
B_V_DIM = 2 * B_HEAD_DIM
B_QK_WIDTH = B_HEADS * 2 * B_HEAD_DIM
B_WIDTH = B_HEADS * B_V_DIM

C_WIDTH = 512
C_KERNEL = 31

D_HEADS = 8
D_KV_HEADS = 2
D_GROUP = D_HEADS // D_KV_HEADS
D_HEAD_DIM = 64
D_WIDTH = D_HEADS * D_HEAD_DIM
D_KV_WIDTH = D_KV_HEADS * D_HEAD_DIM
WINDOW = 128

AB_CUTS = (A_WIDTH, 2 * A_WIDTH, 3 * A_WIDTH, 3 * A_WIDTH + B_QK_WIDTH,
           3 * A_WIDTH + 2 * B_QK_WIDTH, 3 * A_WIDTH + 2 * B_QK_WIDTH + B_WIDTH)
AB_IN = AB_CUTS[-1] + B_WIDTH
AB_MIX = A_WIDTH + B_WIDTH
CD_CUTS = (C_WIDTH, 2 * C_WIDTH, 3 * C_WIDTH, 3 * C_WIDTH + D_WIDTH,
           3 * C_WIDTH + D_WIDTH + D_KV_WIDTH, 3 * C_WIDTH + D_WIDTH + 2 * D_KV_WIDTH)
CD_IN = CD_CUTS[-1] + D_WIDTH
CD_MIX = C_WIDTH + D_WIDTH

N_AB = (DEPTH + 1) // 2
N_CD = DEPTH // 2

kernel_name = "hybrid_diffusion_gmlp_diffattn_conformer_swa"


def layer_norm(x, g, b):
    xf = x.astype(jnp.float32)
    mu = jnp.mean(xf, axis=-1, keepdims=True)
    var = jnp.mean(jnp.square(xf - mu), axis=-1, keepdims=True)
    return ((xf - mu) * lax.rsqrt(var + LN_EPS)).astype(x.dtype) * g + b


def rms_norm(x, g):
    xf = x.astype(jnp.float32)
    return (xf * lax.rsqrt(jnp.mean(xf * xf, axis=-1, keepdims=True) + RMS_EPS)).astype(x.dtype) * g


def axial_rope_tables(rows, head_dim):
    m = head_dim // 4
    inv = ROPE_THETA ** (-jnp.arange(m, dtype=jnp.float32) / m)
    r, col = jnp.meshgrid(jnp.arange(rows, dtype=jnp.float32), jnp.arange(GRID_W, dtype=jnp.float32), indexing="ij")
    ang_r = r.reshape(-1, 1) * inv
    ang_c = col.reshape(-1, 1) * inv
    return (jnp.cos(ang_r), jnp.sin(ang_r), jnp.cos(ang_c), jnp.sin(ang_c))


def _rotate(x, cos, sin):
    x1, x2 = jnp.split(x, 2, axis=-1)
    cos = cos[None, :, None, :].astype(x.dtype)
    sin = sin[None, :, None, :].astype(x.dtype)
    return jnp.concatenate([x1 * cos - x2 * sin, x2 * cos + x1 * sin], axis=-1)


def apply_axial_rope(x, rope):
    cr, sr, cc, sc = rope
    xr, xc = jnp.split(x, 2, axis=-1)
    return jnp.concatenate([_rotate(xr, cr, sr), _rotate(xc, cc, sc)], axis=-1)


def chunk_gmlp(u, v, w_s, b_s, g, bb):
    bsz, n, _ = v.shape
    u = jax.nn.gelu(u)
    v = layer_norm(jax.nn.gelu(v), g, bb)
    vc = v.reshape(bsz, n // CHUNK, CHUNK, A_GROUPS, A_GROUP_DIM)
    mixed = jnp.einsum("gpq,bcqgd->bcpgd", w_s, vc) + b_s.T[None, None, :, :, None]
    return u * mixed.reshape(bsz, n, A_WIDTH)


def diff_attend(q, k, v, lam):
    s = jnp.einsum("bqhcd,bkhcd->bhcqk", q, k).astype(jnp.float32) * (B_HEAD_DIM ** -0.5)
    p = jax.nn.softmax(s, axis=-1)
    w = p[:, :, 0] - lam * p[:, :, 1]
    return jnp.einsum("bhqk,bkhd->bqhd", w.astype(v.dtype), v)


def diff_heads_out(o, subln_g, lam_init):
    bsz, n = o.shape[0], o.shape[1]
    return (rms_norm(o, subln_g) * (1.0 - lam_init)).reshape(bsz, n, B_WIDTH)


def conformer_conv(a, b, dw_w, dw_b, g, bb):
    h = a * jax.nn.sigmoid(b)
    y = lax.conv_general_dilated(h, dw_w[:, None, :].astype(h.dtype), window_strides=(1,),
                                 padding=[(C_KERNEL // 2, C_KERNEL // 2)],
                                 dimension_numbers=("NWC", "WIO", "NWC"),
                                 feature_group_count=C_WIDTH) + dw_b
    return jax.nn.silu(layer_norm(y, g, bb))


def sink_gqa_attend(q, k, v, mask, sink):
    s = jnp.einsum("bqhgd,bkhd->bhgqk", q, k).astype(jnp.float32) * (D_HEAD_DIM ** -0.5)
    if mask is not None:
        s = jnp.where(mask, s, NEG_INF)
    sink_col = jnp.broadcast_to(sink.astype(jnp.float32)[None, :, :, None, None], s.shape[:-1] + (1,))
    p = jax.nn.softmax(jnp.concatenate([s, sink_col], axis=-1), axis=-1)[..., :-1]
    o = jnp.einsum("bhgqk,bkhd->bqhgd", p.astype(v.dtype), v)
    return o.reshape(o.shape[0], o.shape[1], D_WIDTH)


def ab_sublayer(u_lat, u_ctx, need_ctx, rope, layer, w_in, w_out, w_s, b_s, an_g, an_b,
                lq1, lk1, lq2, lk2, subln_g):
    bsz, n, _ = u_lat.shape
    au, av, ag, bq, bk, bv, bg = jnp.split(u_lat @ w_in, AB_CUTS, axis=-1)
    if need_ctx:
        cau, cav, cag, cbq, cbk, cbv, cbg = jnp.split(u_ctx @ w_in, AB_CUTS, axis=-1)
    else:
        cbk, cbv = jnp.split(u_ctx @ w_in[:, AB_CUTS[3]:AB_CUTS[5]], [B_QK_WIDTH], axis=-1)
    lam_init = 0.8 - 0.6 * math.exp(-0.3 * layer)
    lam = (jnp.exp(jnp.sum(lq1.astype(jnp.float32) * lk1.astype(jnp.float32)))
           - jnp.exp(jnp.sum(lq2.astype(jnp.float32) * lk2.astype(jnp.float32))) + lam_init)
    q = apply_axial_rope(bq.reshape(bsz, n, 2 * B_HEADS, B_HEAD_DIM), rope).reshape(bsz, n, B_HEADS, 2, B_HEAD_DIM)
    k = apply_axial_rope(bk.reshape(bsz, n, 2 * B_HEADS, B_HEAD_DIM), rope).reshape(bsz, n, B_HEADS, 2, B_HEAD_DIM)
    v = bv.reshape(bsz, n, B_HEADS, B_V_DIM)
    ck = cbk.reshape(bsz, CTX_LEN, B_HEADS, 2, B_HEAD_DIM)
    cv = cbv.reshape(bsz, CTX_LEN, B_HEADS, B_V_DIM)
    k_all = jnp.concatenate([ck, k], axis=1)
    v_all = jnp.concatenate([cv, v], axis=1)
    q_blocks = q.reshape(bsz, n // Q_BLOCK, Q_BLOCK, B_HEADS, 2, B_HEAD_DIM).swapaxes(0, 1)
    o = lax.map(lambda qb: diff_attend(qb, k_all, v_all, lam), q_blocks)
    b_lat = diff_heads_out(o.swapaxes(0, 1).reshape(bsz, n, B_HEADS, B_V_DIM), subln_g, lam_init)
    a_lat = chunk_gmlp(au, av, w_s, b_s, an_g, an_b)
    y_lat = jnp.concatenate([a_lat * jax.nn.silu(ag), b_lat * jax.nn.silu(bg)], axis=-1) @ w_out
    y_ctx = None
    if need_ctx:
        cq = cbq.reshape(bsz, CTX_LEN, B_HEADS, 2, B_HEAD_DIM)
        b_ctx = diff_heads_out(diff_attend(cq, ck, cv, lam), subln_g, lam_init)
        a_ctx = chunk_gmlp(cau, cav, w_s, b_s, an_g, an_b)
        y_ctx = jnp.concatenate([a_ctx * jax.nn.silu(cag), b_ctx * jax.nn.silu(cbg)], axis=-1) @ w_out
    return y_lat, y_ctx


def cd_sublayer(u_lat, u_ctx, need_ctx, rope, w_in, w_out, dw_w, dw_b, cn_g, cn_b, sink_logit):
    bsz, n, _ = u_lat.shape
    ca, cb, cg, dq, dk, dv, dg = jnp.split(u_lat @ w_in, CD_CUTS, axis=-1)
    if need_ctx:
        cca, ccb, ccg, cdq, cdk, cdv, cdg = jnp.split(u_ctx @ w_in, CD_CUTS, axis=-1)
    else:
        cdk, cdv = jnp.split(u_ctx @ w_in[:, CD_CUTS[3]:CD_CUTS[5]], [D_KV_WIDTH], axis=-1)
    ck = cdk.reshape(bsz, CTX_LEN, D_KV_HEADS, D_HEAD_DIM)
    cv = cdv.reshape(bsz, CTX_LEN, D_KV_HEADS, D_HEAD_DIM)
    sink = sink_logit.reshape(D_KV_HEADS, D_GROUP)
    q = apply_axial_rope(dq.reshape(bsz, n, D_HEADS, D_HEAD_DIM), rope).reshape(bsz, n, D_KV_HEADS, D_GROUP, D_HEAD_DIM)
    k = apply_axial_rope(dk.reshape(bsz, n, D_KV_HEADS, D_HEAD_DIM), rope)
    v = dv.reshape(bsz, n, D_KV_HEADS, D_HEAD_DIM)
    pad = ((0, 0), (WINDOW, WINDOW), (0, 0), (0, 0))
    kp, vp = jnp.pad(k, pad), jnp.pad(v, pad)
    band_len = Q_BLOCK + 2 * WINDOW
    ctx_mask = jnp.ones((Q_BLOCK, CTX_LEN), dtype=bool)

    def band_block(i):
        start = i * Q_BLOCK
        qb = lax.dynamic_slice_in_dim(q, start, Q_BLOCK, axis=1)
        kb = lax.dynamic_slice_in_dim(kp, start, band_len, axis=1)
        vb = lax.dynamic_slice_in_dim(vp, start, band_len, axis=1)
        qpos = start + jnp.arange(Q_BLOCK)
        kpos = start - WINDOW + jnp.arange(band_len)
        band = ((jnp.abs(qpos[:, None] - kpos[None, :]) <= WINDOW)
                & (kpos >= 0)[None, :] & (kpos < n)[None, :])
        mask = jnp.concatenate([band, ctx_mask], axis=1)
        return sink_gqa_attend(qb, jnp.concatenate([kb, ck], axis=1), jnp.concatenate([vb, cv], axis=1), mask, sink)

    d_lat = lax.map(band_block, jnp.arange(n // Q_BLOCK)).swapaxes(0, 1).reshape(bsz, n, D_WIDTH)
    c_lat = conformer_conv(ca, cb, dw_w, dw_b, cn_g, cn_b)
    y_lat = jnp.concatenate([c_lat * jax.nn.silu(cg), d_lat * jax.nn.silu(dg)], axis=-1) @ w_out
    y_ctx = None
    if need_ctx:
        cq = cdq.reshape(bsz, CTX_LEN, D_KV_HEADS, D_GROUP, D_HEAD_DIM)
        d_ctx = sink_gqa_attend(cq, ck, cv, None, sink)
        c_ctx_out = conformer_conv(cca, ccb, dw_w, dw_b, cn_g, cn_b)
        y_ctx = jnp.concatenate([c_ctx_out * jax.nn.silu(ccg), d_ctx * jax.nn.silu(cdg)], axis=-1) @ w_out
    return y_lat, y_ctx


def setup_inputs(seed: int = 0) -> dict:
    key = jax.random.key(seed)
    ks = jax.random.split(key, 32)
    f32 = jnp.float32
    beta = (8.0 * DEPTH) ** -0.25

    def nrm(k, shape, s):
        return jax.random.normal(k, shape, f32) * s

    return {
        "x": nrm(ks[0], (BATCH, SEQ, D_MODEL), 1.0),
        "c": nrm(ks[1], (BATCH, D_MODEL), 1.0),
        "ctx": nrm(ks[2], (BATCH, CTX_LEN, D_MODEL), 1.0),
        "c_ctx": nrm(ks[3], (D_MODEL,), 1.0),
        "mod_w": nrm(ks[4], (DEPTH, D_MODEL, 3 * D_MODEL), D_MODEL ** -0.5),
        "mod_b": nrm(ks[5], (DEPTH, 3 * D_MODEL), 0.02),
        "ln_g": 1.0 + nrm(ks[6], (DEPTH, D_MODEL), 0.02),
        "ln_b": nrm(ks[7], (DEPTH, D_MODEL), 0.02),
        "ab_w_in": nrm(ks[8], (N_AB, D_MODEL, AB_IN), D_MODEL ** -0.5),
        "ab_w_out": nrm(ks[9], (N_AB, AB_MIX, D_MODEL), beta * AB_MIX ** -0.5),
        "a_w_s": nrm(ks[10], (N_AB, A_GROUPS, CHUNK, CHUNK), CHUNK ** -0.5),
        "a_b_s": 1.0 + nrm(ks[11], (N_AB, A_GROUPS, CHUNK), 0.02),
        "a_norm_g": 1.0 + nrm(ks[12], (N_AB, A_WIDTH), 0.02),
        "a_norm_b": nrm(ks[13], (N_AB, A_WIDTH), 0.02),
        "b_lq1": nrm(ks[14], (N_AB, B_HEAD_DIM), 0.1),
        "b_lk1": nrm(ks[15], (N_AB, B_HEAD_DIM), 0.1),
        "b_lq2": nrm(ks[16], (N_AB, B_HEAD_DIM), 0.1),
        "b_lk2": nrm(ks[17], (N_AB, B_HEAD_DIM), 0.1),
        "b_subln_g": 1.0 + nrm(ks[18], (N_AB, B_V_DIM), 0.02),
        "cd_w_in": nrm(ks[19], (N_CD, D_MODEL, CD_IN), D_MODEL ** -0.5),
        "cd_w_out": nrm(ks[20], (N_CD, CD_MIX, D_MODEL), beta * CD_MIX ** -0.5),
        "c_dw_w": nrm(ks[21], (N_CD, C_KERNEL, C_WIDTH), C_KERNEL ** -0.5),
        "c_dw_b": nrm(ks[22], (N_CD, C_WIDTH), 0.02),
        "c_norm_g": 1.0 + nrm(ks[23], (N_CD, C_WIDTH), 0.02),
        "c_norm_b": nrm(ks[24], (N_CD, C_WIDTH), 0.02),
        "d_sink": nrm(ks[25], (N_CD, D_HEADS), 0.5),
    }


def reference(x, c, ctx, c_ctx, mod_w, mod_b, ln_g, ln_b, ab_w_in, ab_w_out, a_w_s, a_b_s,
              a_norm_g, a_norm_b, b_lq1, b_lk1, b_lq2, b_lk2, b_subln_g, cd_w_in, cd_w_out,
              c_dw_w, c_dw_b, c_norm_g, c_norm_b, d_sink):
    n = x.shape[1]
    rows = n // GRID_W
    rope = axial_rope_tables(rows, B_HEAD_DIM)
    alpha = (2.0 * DEPTH) ** 0.25
    silu_c = jax.nn.silu(c)
    silu_cc = jax.nn.silu(c_ctx)
    h_lat, h_ctx = x, ctx
    for layer in range(DEPTH):
        need_ctx = layer < DEPTH - 1
        shift, scale, gate = jnp.split(silu_c @ mod_w[layer] + mod_b[layer], 3, axis=-1)
        shift_c, scale_c, gate_c = jnp.split(silu_cc @ mod_w[layer] + mod_b[layer], 3, axis=-1)
        u_lat = h_lat * (1.0 + scale[:, None, :]) + shift[:, None, :]
        u_ctx = h_ctx * (1.0 + scale_c) + shift_c
        if layer % 2 == 0:
            i = layer // 2
            y_lat, y_ctx = ab_sublayer(u_lat, u_ctx, need_ctx, rope, layer, ab_w_in[i], ab_w_out[i],
                                       a_w_s[i], a_b_s[i], a_norm_g[i], a_norm_b[i],
                                       b_lq1[i], b_lk1[i], b_lq2[i], b_lk2[i], b_subln_g[i])
        else:
            i = layer // 2
            y_lat, y_ctx = cd_sublayer(u_lat, u_ctx, need_ctx, rope, cd_w_in[i], cd_w_out[i],
                                       c_dw_w[i], c_dw_b[i], c_norm_g[i], c_norm_b[i], d_sink[i])
        new_lat = layer_norm(alpha * h_lat + gate[:, None, :] * y_lat, ln_g[layer], ln_b[layer])
        if need_ctx:
            h_ctx = layer_norm(alpha * h_ctx + gate_c * y_ctx, ln_g[layer], ln_b[layer])
        h_lat = new_lat
    return h_lat
```

```cpp
#include <hip/hip_runtime.h>
#include <cstdio>
#include <cstdint>
#include <cmath>

typedef unsigned short bf16_t;
typedef short bf16x8 __attribute__((ext_vector_type(8)));
typedef float f32x4 __attribute__((ext_vector_type(4)));
typedef float f32x16 __attribute__((ext_vector_type(16)));
typedef unsigned u32x4 __attribute__((ext_vector_type(4)));
typedef unsigned u32x2 __attribute__((ext_vector_type(2)));

constexpr int NB = 16, NS = 2048, DM = 1024, NC = 256;
constexpr int MLAT = NB * NS, MCTX = NB * NC, MTOT = MLAT + MCTX;
constexpr int N0 = 3584, N1 = 2816, P1W = 2304;
constexpr float LN_EPS = 1e-6f, RMS_EPS = 1e-5f;
constexpr float ALPHA = 1.41421356237f;
constexpr float LOG2E = 1.4426950408889634f;
constexpr float C2 = 0.125f * LOG2E;
constexpr float LAM_INIT0 = 0.2f;

constexpr size_t MiB = 1u << 20;
constexpr size_t WS_CTL = 0;
constexpr size_t WS_MODS = 1 * MiB;
constexpr size_t WS_ROPE = 2 * MiB;
constexpr size_t WS_WSB = 2 * MiB + 65536;
constexpr size_t WS_STATS = 3 * MiB;
constexpr size_t WS_W0T = 4 * MiB;
constexpr size_t WS_WO0T = 12 * MiB;
constexpr size_t WS_W1T = 14 * MiB;
constexpr size_t WS_WO1T = 20 * MiB;
constexpr size_t WS_ZC = 22 * MiB;
constexpr size_t WS_A = 38 * MiB;
constexpr size_t WS_B = 110 * MiB;
constexpr size_t WS_T = 362 * MiB;
constexpr size_t WS_END = 506 * MiB;

__device__ __forceinline__ unsigned f2bf(float f) { unsigned u = __builtin_bit_cast(unsigned, f); return (u + 0x7fffu + ((u >> 16) & 1u)) >> 16; }
__device__ __forceinline__ float bf2f(bf16_t h) { return __builtin_bit_cast(float, (unsigned)h << 16); }
__device__ __forceinline__ unsigned pk2(float lo, float hi) { return f2bf(lo) | (f2bf(hi) << 16); }
__device__ __forceinline__ float silu_f(float v) { return v / (1.f + __expf(-v)); }
__device__ __forceinline__ float sigmoid_f(float v) { return 1.f / (1.f + __expf(-v)); }
__device__ __forceinline__ float gelu_tanh_f(float v) {
    const float u = 0.7978845608028654f * (v + 0.044715f * v * v * v);
    return v / (1.f + __expf(-2.f * u));
}
__device__ __forceinline__ float wave_sum(float v) {
#pragma unroll
    for (int o = 1; o < 64; o <<= 1) v += __shfl_xor(v, o);
    return v;
}
__device__ __forceinline__ int crow(int r, int hi) { return (r & 3) + 8 * (r >> 2) + 4 * hi; }

template <int MODE> __device__ __forceinline__ int w_src_col(int np) {
    if (MODE == 1) {
        if (np < 1024) { const int j = np >> 8, w = np & 255; return w < 128 ? 128 * j + w : 512 + 128 * j + (w - 128); }
        return np;
    }
    return np;
}
template <int MODE> __global__ void k_transpose(const float* __restrict__ W, int N, bf16_t* __restrict__ Wt) {
    __shared__ float tile[32][33];
    const int k0 = blockIdx.x * 32, n0 = blockIdx.y * 32, tx = threadIdx.x & 31, ty = threadIdx.x >> 5;
    for (int i = ty; i < 32; i += 8) { const int np = n0 + tx; tile[i][tx] = W[(size_t)(k0 + i) * N + w_src_col<MODE>(np)]; }
    __syncthreads();
    for (int i = ty; i < 32; i += 8) Wt[(size_t)(n0 + i) * 1024 + k0 + tx] = (bf16_t)f2bf(tile[tx][i]);
}
__global__ void k_mods(const float* __restrict__ c, const float* __restrict__ c_ctx, const float* __restrict__ mod_w, const float* __restrict__ mod_b, float* __restrict__ mods) {
    const int idx = blockIdx.x * blockDim.x + threadIdx.x;
    if (idx >= 2 * 17 * 3072) return;
    const int col = idx % 3072, bp = (idx / 3072) % 17, l = idx / (3072 * 17);
    const float* cv = bp < 16 ? c + bp * 1024 : c_ctx;
    const float* w = mod_w + (size_t)l * 1024 * 3072 + col;
    float acc = 0.f;
    for (int k = 0; k < 1024; ++k) acc += silu_f(cv[k]) * w[(size_t)k * 3072];
    mods[idx] = acc + mod_b[l * 3072 + col];
}
__global__ void k_misc(const float* __restrict__ a_w_s, bf16_t* __restrict__ wsb, float* __restrict__ rope) {
    const int idx = blockIdx.x * blockDim.x + threadIdx.x;
    if (idx < 4 * 128 * 128) wsb[idx] = (bf16_t)f2bf(a_w_s[idx]);
    if (idx < 64 * 16) { const int pos = idx >> 4, j = idx & 15; const float inv = powf(10000.f, -(float)j / 16.f); const float ang = (float)pos * inv;
        rope[idx] = cosf(ang); rope[1024 + idx] = sinf(ang); }
}

template <int MODE> __device__ __forceinline__ void row_op(const float* in, float* outf, bf16_t* outb, const float* g, const float* b, const float* shift, const float* scale, int lane) {
    const f32x4* xr = (const f32x4*)in + lane;
    f32x4 v[4];
#pragma unroll
    for (int j = 0; j < 4; ++j) v[j] = xr[64 * j];
    if (MODE >= 1) {
        float s = 0.f;
#pragma unroll
        for (int j = 0; j < 4; ++j) s += (v[j][0] + v[j][1]) + (v[j][2] + v[j][3]);
        const float mean = wave_sum(s) * (1.f / 1024.f); float s2 = 0.f;
#pragma unroll
        for (int j = 0; j < 4; ++j) { v[j] = v[j] - mean; s2 += (v[j][0] * v[j][0] + v[j][1] * v[j][1]) + (v[j][2] * v[j][2] + v[j][3] * v[j][3]); }
        const float rstd = 1.f / sqrtf(wave_sum(s2) * (1.f / 1024.f) + LN_EPS);
#pragma unroll
        for (int j = 0; j < 4; ++j) { const f32x4 gg = ((const f32x4*)g)[lane + 64 * j], bb = ((const f32x4*)b)[lane + 64 * j]; v[j] = v[j] * rstd * gg + bb; }
        if (outf) {
#pragma unroll
            for (int j = 0; j < 4; ++j) ((f32x4*)outf)[lane + 64 * j] = v[j];
        }
    }
    if (MODE <= 1) {
#pragma unroll
        for (int j = 0; j < 4; ++j) { const f32x4 sc = ((const f32x4*)scale)[lane + 64 * j], sh = ((const f32x4*)shift)[lane + 64 * j];
            const f32x4 u = v[j] * (1.f + sc) + sh; u32x2 w; w[0] = pk2(u[0], u[1]); w[1] = pk2(u[2], u[3]);
            ((u32x2*)outb)[lane + 64 * j] = w; }
    }
}
__global__ void k_p1(const float* __restrict__ x, const float* __restrict__ ctx, const float* __restrict__ mods, bf16_t* __restrict__ u0) {
    const int lane = threadIdx.x & 63; const int row = blockIdx.x * (blockDim.x >> 6) + (threadIdx.x >> 6);
    if (row >= MTOT) return;
    const int bp = row < MLAT ? row / NS : 16; const float* in = row < MLAT ? x + (size_t)row * DM : ctx + (size_t)(row - MLAT) * DM;
    const float* md = mods + (size_t)(0 * 17 + bp) * 3072;
    row_op<0>(in, nullptr, u0 + (size_t)row * DM, nullptr, nullptr, md, md + 1024, lane);
}
__global__ void k_p5(float* __restrict__ out, const float* __restrict__ zc, const float* __restrict__ mods, const float* __restrict__ ln_g, const float* __restrict__ ln_b, bf16_t* __restrict__ u1) {
    const int lane = threadIdx.x & 63; const int row = blockIdx.x * (blockDim.x >> 6) + (threadIdx.x >> 6);
    if (row >= MTOT) return;
    const int bp = row < MLAT ? row / NS : 16; const float* md = mods + (size_t)(1 * 17 + bp) * 3072;
    if (row < MLAT) row_op<1>(out + (size_t)row * DM, out + (size_t)row * DM, u1 + (size_t)row * DM, ln_g, ln_b, md, md + 1024, lane);
    else row_op<1>(zc + (size_t)(row - MLAT) * DM, nullptr, u1 + (size_t)row * DM, ln_g, ln_b, md, md + 1024, lane);
}
__global__ void k_p9(float* __restrict__ out, const float* __restrict__ ln_g, const float* __restrict__ ln_b) {
    const int lane = threadIdx.x & 63; const int row = blockIdx.x * (blockDim.x >> 6) + (threadIdx.x >> 6);
    if (row >= MLAT) return;
    row_op<2>(out + (size_t)row * DM, out + (size_t)row * DM, nullptr, ln_g + 1024, ln_b + 1024, nullptr, nullptr, lane);
}

__device__ __forceinline__ f32x16 mm_tile(const bf16_t* A, const bf16_t* Bt, int m0, int n0, int lane) {
    const int r32 = lane & 31, hi = lane >> 5;
    const bf16_t* a = A + (size_t)(m0 + r32) * 1024 + 8 * hi; const bf16_t* b = Bt + (size_t)(n0 + r32) * 1024 + 8 * hi;
    f32x16 acc = {};
#pragma unroll 4
    for (int k = 0; k < 1024; k += 16) { const bf16x8 fa = *(const bf16x8*)(a + k), fb = *(const bf16x8*)(b + k); acc = __builtin_amdgcn_mfma_f32_32x32x16_bf16(fa, fb, acc, 0, 0, 0); }
    return acc;
}
__device__ __forceinline__ float rope_val(float v, float partner, int d, int t, const float* __restrict__ rope) {
    const int half = d >> 5, i = d & 31, j = i & 15; const int pos = half ? (t & 63) : (t >> 6);
    const float cs = rope[pos * 16 + j], sn = rope[1024 + pos * 16 + j];
    return (i < 16) ? v * cs - partner * sn : v * cs + partner * sn;
}
__global__ void __launch_bounds__(256) k_gemm_in0(const bf16_t* __restrict__ A, const bf16_t* __restrict__ Bt, bf16_t* __restrict__ out, const float* __restrict__ rope) {
    const int lane = threadIdx.x & 63, w = threadIdx.x >> 6, r32 = lane & 31, hi = lane >> 5;
    const int m0 = blockIdx.y * 32, n0 = blockIdx.x * 128 + w * 32;
    const f32x16 acc = mm_tile(A, Bt, m0, n0, lane);
    const int n = n0 + r32;
#pragma unroll
    for (int r = 0; r < 16; ++r) {
        const int row = m0 + crow(r, hi); float v = acc[r];
        const float partner = __shfl_xor(v, 16);
        if (n < 1024) v = gelu_tanh_f(v);
        else if (n < 1536) v = silu_f(v);
        else if (n < 2560) { if (row < MLAT) v = rope_val(v, partner, n & 63, row & (NS - 1), rope); if (n < 2048) v *= C2; }
        else if (n >= 3072) v = silu_f(v);
        out[(size_t)row * N0 + n] = (bf16_t)f2bf(v);
    }
}
__global__ void __launch_bounds__(256) k_gemm_in1(const bf16_t* __restrict__ A, const bf16_t* __restrict__ Bt, bf16_t* __restrict__ out, const float* __restrict__ rope) {
    const int lane = threadIdx.x & 63, w = threadIdx.x >> 6, r32 = lane & 31, hi = lane >> 5;
    const int m0 = blockIdx.y * 32, n0 = blockIdx.x * 128 + w * 32;
    const bool ctxrow = m0 >= MLAT;
    if (ctxrow && (n0 < 2048 || n0 >= 2304)) return;
    if (n0 < 1024) {
        if ((n0 & 255) >= 128) return;
        const f32x16 a = mm_tile(A, Bt, m0, n0, lane), b = mm_tile(A, Bt, m0, n0 + 128, lane);
        const int oc = (n0 >> 8) * 128 + (n0 & 127) + r32;
#pragma unroll
        for (int r = 0; r < 16; ++r) out[(size_t)(m0 + crow(r, hi)) * P1W + oc] = (bf16_t)f2bf(a[r] * sigmoid_f(b[r]));
        return;
    }
    const f32x16 acc = mm_tile(A, Bt, m0, n0, lane);
    const int n = n0 + r32;
#pragma unroll
    for (int r = 0; r < 16; ++r) {
        const int row = m0 + crow(r, hi); float v = acc[r];
        const float partner = __shfl_xor(v, 16);
        if (n < 1536) v = silu_f(v);
        else if (n < 2176) { if (row < MLAT) v = rope_val(v, partner, n & 63, row & (NS - 1), rope); if (n < 2048) v *= C2; }
        else if (n >= 2304) v = silu_f(v);
        out[(size_t)row * P1W + (n - 512)] = (bf16_t)f2bf(v);
    }
}
__global__ void __launch_bounds__(256) k_gemm_out(const bf16_t* __restrict__ A, const bf16_t* __restrict__ Bt, const float* hlat, const float* __restrict__ hctx,
                                                  const float* __restrict__ mods_l, float* zlat, float* __restrict__ zctx) {
    const int lane = threadIdx.x & 63, w = threadIdx.x >> 6, r32 = lane & 31, hi = lane >> 5;
    const int m0 = blockIdx.y * 32, n0 = blockIdx.x * 128 + w * 32;
    const f32x16 acc = mm_tile(A, Bt, m0, n0, lane);
    const int n = n0 + r32;
#pragma unroll
    for (int r = 0; r < 16; ++r) {
        const int row = m0 + crow(r, hi);
        if (row < MLAT) { const float gate = mods_l[(size_t)(row / NS) * 3072 + 2048 + n]; const size_t o = (size_t)row * DM + n; zlat[o] = ALPHA * hlat[o] + gate * acc[r]; }
        else { const float gate = mods_l[(size_t)16 * 3072 + 2048 + n]; const size_t o = (size_t)(row - MLAT) * DM + n; zctx[o] = ALPHA * hctx[o] + gate * acc[r]; }
    }
}

__global__ void __launch_bounds__(256) k_diffattn(const bf16_t* __restrict__ P, float* __restrict__ tmp) {
    const int idx = blockIdx.x * blockDim.x + threadIdx.x;
    const int row = idx % MTOT, hc = idx / MTOT; if (hc >= 8) return;
    const int h = hc >> 1, c = hc & 1;
    const bool lat = row < MLAT; const int b = lat ? row / NS : (row - MLAT) / NC;
    float q[64];
    { const bf16_t* qp = P + (size_t)row * N0 + 1536 + h * 128 + c * 64;
#pragma unroll
      for (int d = 0; d < 64; ++d) q[d] = bf2f(qp[d]); }
    float o[128];
#pragma unroll
    for (int d = 0; d < 128; ++d) o[d] = 0.f;
    float m = -1e30f, l = 0.f;
    const int nk = lat ? NC + NS : NC;
    for (int j = 0; j < nk; ++j) {
        const int krow = j < NC ? MLAT + b * NC + j : b * NS + (j - NC);
        const bf16_t* kp = P + (size_t)krow * N0 + 2048 + h * 128 + c * 64; const bf16_t* vp = P + (size_t)krow * N0 + 2560 + h * 128;
        float s = 0.f;
#pragma unroll
        for (int d8 = 0; d8 < 8; ++d8) { const bf16x8 kk = *(const bf16x8*)(kp + d8 * 8);
#pragma unroll
            for (int e = 0; e < 8; ++e) s += q[d8 * 8 + e] * bf2f((bf16_t)kk[e]); }
        const float mn = fmaxf(m, s), f = exp2f(m - mn), p = exp2f(s - mn);
        l = l * f + p; m = mn;
#pragma unroll
        for (int d8 = 0; d8 < 16; ++d8) { const bf16x8 vv = *(const bf16x8*)(vp + d8 * 8);
#pragma unroll
            for (int e = 0; e < 8; ++e) o[d8 * 8 + e] = o[d8 * 8 + e] * f + p * bf2f((bf16_t)vv[e]); }
    }
    const float il = 1.f / l; float* op = tmp + ((size_t)row * 8 + hc) * 128;
#pragma unroll
    for (int d = 0; d < 128; ++d) op[d] = o[d] * il;
}
__global__ void k_diffcombine(const float* __restrict__ tmp, const bf16_t* __restrict__ P, const float* __restrict__ lq1, const float* __restrict__ lk1, const float* __restrict__ lq2,
                              const float* __restrict__ lk2, const float* __restrict__ subg, bf16_t* __restrict__ mix) {
    const int lane = threadIdx.x & 63; const int wv = blockIdx.x * (blockDim.x >> 6) + (threadIdx.x >> 6);
    if (wv >= MTOT * 4) return;
    const int row = wv >> 2, h = wv & 3;
    const float lam = __expf(wave_sum(lq1[lane] * lk1[lane])) - __expf(wave_sum(lq2[lane] * lk2[lane])) + LAM_INIT0;
    const float* o1 = tmp + ((size_t)row * 8 + h * 2) * 128; const float* o2 = o1 + 128;
    const float a0 = o1[lane] - lam * o2[lane], a1 = o1[lane + 64] - lam * o2[lane + 64];
    const float r = 1.f / sqrtf(wave_sum(a0 * a0 + a1 * a1) * (1.f / 128.f) + RMS_EPS);
    const bf16_t* bg = P + (size_t)row * N0 + 3072 + h * 128; bf16_t* mo = mix + (size_t)row * DM + 512 + h * 128;
    mo[lane] = (bf16_t)f2bf(a0 * r * subg[lane] * (1.f - LAM_INIT0) * bf2f(bg[lane]));
    mo[lane + 64] = (bf16_t)f2bf(a1 * r * subg[lane + 64] * (1.f - LAM_INIT0) * bf2f(bg[lane + 64]));
}
__global__ void k_gmlp_stats(const bf16_t* __restrict__ P, float* __restrict__ stats) {
    const int lane = threadIdx.x & 63; const int row = blockIdx.x * (blockDim.x >> 6) + (threadIdx.x >> 6);
    if (row >= MTOT) return;
    const bf16x8 v = *(const bf16x8*)(P + (size_t)row * N0 + 512 + lane * 8);
    float f[8], s = 0.f;
#pragma unroll
    for (int e = 0; e < 8; ++e) { f[e] = bf2f((bf16_t)v[e]); s += f[e]; }
    const float mean = wave_sum(s) * (1.f / 512.f); float s2 = 0.f;
#pragma unroll
    for (int e = 0; e < 8; ++e) { const float d = f[e] - mean; s2 += d * d; }
    const float rstd = 1.f / sqrtf(wave_sum(s2) * (1.f / 512.f) + LN_EPS);
    if (lane == 0) { stats[2 * row] = mean; stats[2 * row + 1] = rstd; }
}
__global__ void __launch_bounds__(256) k_gmlp(const bf16_t* __restrict__ P, const float* __restrict__ stats, const float* __restrict__ a_w_s, const float* __restrict__ a_b_s,
                                             const float* __restrict__ ng, const float* __restrict__ nb, bf16_t* __restrict__ mix) {
    const int idx = blockIdx.x * blockDim.x + threadIdx.x; const int col = idx & 511, row = idx >> 9; if (row >= MTOT) return;
    const int g = col >> 7, p = row & 127, row0 = row - p;
    const float* w = a_w_s + ((size_t)g * 128 + p) * 128; const float gg = ng[col], bb = nb[col];
    float acc = 0.f;
    for (int q = 0; q < 128; ++q) { const int rq = row0 + q; const float v = bf2f(P[(size_t)rq * N0 + 512 + col]); acc += w[q] * ((v - stats[2 * rq]) * stats[2 * rq + 1] * gg + bb); }
    acc += a_b_s[g * 128 + p];
    const float u = bf2f(P[(size_t)row * N0 + col]), ag = bf2f(P[(size_t)row * N0 + 1024 + col]);
    mix[(size_t)row * DM + col] = (bf16_t)f2bf(u * acc * ag);
}
__global__ void __launch_bounds__(256) k_winattn(const bf16_t* __restrict__ P, const float* __restrict__ sink, bf16_t* __restrict__ mix) {
    const int idx = blockIdx.x * blockDim.x + threadIdx.x; const int row = idx % MLAT, h = idx / MLAT; if (h >= 8) return;
    const int b = row / NS, t = row % NS, kvh = h >> 2;
    float q[64];
    { const bf16_t* qp = P + (size_t)row * P1W + 1024 + h * 64;
#pragma unroll
      for (int d = 0; d < 64; ++d) q[d] = bf2f(qp[d]); }
    float o[64];
#pragma unroll
    for (int d = 0; d < 64; ++d) o[d] = 0.f;
    float m = sink[h] * LOG2E, l = 1.f;
    const int lo = t - 128 < 0 ? 0 : t - 128, hi = t + 128 > NS - 1 ? NS - 1 : t + 128;
    const int nk = NC + (hi - lo + 1);
    for (int j = 0; j < nk; ++j) {
        const int krow = j < NC ? MLAT + b * NC + j : b * NS + lo + (j - NC);
        const bf16_t* kp = P + (size_t)krow * P1W + 1536 + kvh * 64; const bf16_t* vp = P + (size_t)krow * P1W + 1664 + kvh * 64;
        float s = 0.f;
#pragma unroll
        for (int d8 = 0; d8 < 8; ++d8) { const bf16x8 kk = *(const bf16x8*)(kp + d8 * 8);
#pragma unroll
            for (int e = 0; e < 8; ++e) s += q[d8 * 8 + e] * bf2f((bf16_t)kk[e]); }
        const float mn = fmaxf(m, s), f = exp2f(m - mn), p = exp2f(s - mn);
        l = l * f + p; m = mn;
#pragma unroll
        for (int d8 = 0; d8 < 8; ++d8) { const bf16x8 vv = *(const bf16x8*)(vp + d8 * 8);
#pragma unroll
            for (int e = 0; e < 8; ++e) o[d8 * 8 + e] = o[d8 * 8 + e] * f + p * bf2f((bf16_t)vv[e]); }
    }
    const float il = 1.f / l; const bf16_t* dg = P + (size_t)row * P1W + 1792 + h * 64; bf16_t* mo = mix + (size_t)row * DM + 512 + h * 64;
#pragma unroll
    for (int d = 0; d < 64; ++d) mo[d] = (bf16_t)f2bf(o[d] * il * bf2f(dg[d]));
}
__global__ void __launch_bounds__(256) k_conv(const bf16_t* __restrict__ P, const float* __restrict__ dw_w, const float* __restrict__ dw_b, float* __restrict__ ytmp) {
    const int idx = blockIdx.x * blockDim.x + threadIdx.x; const int c = idx & 511, row = idx >> 9; if (row >= MLAT) return;
    const int t = row % NS; float acc = dw_b[c];
    for (int k = 0; k < 31; ++k) { const int tt = t + k - 15; if (tt >= 0 && tt < NS) acc += dw_w[k * 512 + c] * bf2f(P[(size_t)(row + k - 15) * P1W + c]); }
    ytmp[(size_t)row * 512 + c] = acc;
}
__global__ void k_conv_ln(const float* __restrict__ ytmp, const bf16_t* __restrict__ P, const float* __restrict__ g, const float* __restrict__ b, bf16_t* __restrict__ mix) {
    const int lane = threadIdx.x & 63; const int row = blockIdx.x * (blockDim.x >> 6) + (threadIdx.x >> 6);
    if (row >= MLAT) return;
    float f[8], s = 0.f;
#pragma unroll
    for (int e = 0; e < 8; ++e) { f[e] = ytmp[(size_t)row * 512 + lane * 8 + e]; s += f[e]; }
    const float mean = wave_sum(s) * (1.f / 512.f); float s2 = 0.f;
#pragma unroll
    for (int e = 0; e < 8; ++e) { f[e] -= mean; s2 += f[e] * f[e]; }
    const float rstd = 1.f / sqrtf(wave_sum(s2) * (1.f / 512.f) + LN_EPS);
#pragma unroll
    for (int e = 0; e < 8; ++e) { const int c = lane * 8 + e; const float y = f[e] * rstd * g[c] + b[c];
        mix[(size_t)row * DM + c] = (bf16_t)f2bf(silu_f(y) * bf2f(P[(size_t)row * P1W + 512 + c])); }
}

extern "C" void kernel_launch(void* const* d_in, const int* in_sizes, int n_in, void* d_out, int out_size, void* d_ws, size_t ws_size, hipStream_t stream) {
    if (n_in != 26 || out_size != MLAT * DM || ws_size < WS_END) { fprintf(stderr, "kernel_launch: unexpected shapes (n_in %d out %d ws %zu)\n", n_in, out_size, ws_size); return; }
    const float* x = (const float*)d_in[0]; const float* c = (const float*)d_in[1]; const float* ctx = (const float*)d_in[2]; const float* c_ctx = (const float*)d_in[3];
    const float* mod_w = (const float*)d_in[4]; const float* mod_b = (const float*)d_in[5]; const float* ln_g = (const float*)d_in[6]; const float* ln_b = (const float*)d_in[7];
    const float* ab_w_in = (const float*)d_in[8]; const float* ab_w_out = (const float*)d_in[9]; const float* a_w_s = (const float*)d_in[10]; const float* a_b_s = (const float*)d_in[11];
    const float* a_norm_g = (const float*)d_in[12]; const float* a_norm_b = (const float*)d_in[13];
    const float* lq1 = (const float*)d_in[14]; const float* lk1 = (const float*)d_in[15]; const float* lq2 = (const float*)d_in[16]; const float* lk2 = (const float*)d_in[17];
    const float* subg = (const float*)d_in[18]; const float* cd_w_in = (const float*)d_in[19]; const float* cd_w_out = (const float*)d_in[20];
    const float* dw_w = (const float*)d_in[21]; const float* dw_b = (const float*)d_in[22]; const float* cn_g = (const float*)d_in[23]; const float* cn_b = (const float*)d_in[24];
    const float* sink = (const float*)d_in[25];
    unsigned char* ws = (unsigned char*)d_ws; float* out = (float*)d_out;
    float* mods = (float*)(ws + WS_MODS); float* rope = (float*)(ws + WS_ROPE); bf16_t* wsb = (bf16_t*)(ws + WS_WSB); float* stats = (float*)(ws + WS_STATS);
    bf16_t* W0t = (bf16_t*)(ws + WS_W0T); bf16_t* Wo0t = (bf16_t*)(ws + WS_WO0T); bf16_t* W1t = (bf16_t*)(ws + WS_W1T); bf16_t* Wo1t = (bf16_t*)(ws + WS_WO1T);
    float* zc = (float*)(ws + WS_ZC); bf16_t* bufA = (bf16_t*)(ws + WS_A); bf16_t* bufB = (bf16_t*)(ws + WS_B); float* tmp = (float*)(ws + WS_T);

    k_transpose<0><<<dim3(32, N0 / 32), 256, 0, stream>>>(ab_w_in, N0, W0t);
    k_transpose<0><<<dim3(32, 32), 256, 0, stream>>>(ab_w_out, 1024, Wo0t);
    k_transpose<1><<<dim3(32, N1 / 32), 256, 0, stream>>>(cd_w_in, N1, W1t);
    k_transpose<0><<<dim3(32, 32), 256, 0, stream>>>(cd_w_out, 1024, Wo1t);
    k_mods<<<(2 * 17 * 3072 + 255) / 256, 256, 0, stream>>>(c, c_ctx, mod_w, mod_b, mods);
    k_misc<<<(4 * 128 * 128 + 255) / 256, 256, 0, stream>>>(a_w_s, wsb, rope);
    k_p1<<<MTOT / 4, 256, 0, stream>>>(x, ctx, mods, bufA);
    k_gemm_in0<<<dim3(N0 / 128, MTOT / 32), 256, 0, stream>>>(bufA, W0t, bufB, rope);
    k_diffattn<<<(MTOT * 8) / 256, 256, 0, stream>>>(bufB, tmp);
    k_diffcombine<<<(MTOT * 4) / 4, 256, 0, stream>>>(tmp, bufB, lq1, lk1, lq2, lk2, subg, bufA);
    k_gmlp_stats<<<MTOT / 4, 256, 0, stream>>>(bufB, stats);
    k_gmlp<<<(MTOT * 512) / 256, 256, 0, stream>>>(bufB, stats, a_w_s, a_b_s, a_norm_g, a_norm_b, bufA);
    k_gemm_out<<<dim3(1024 / 128, MTOT / 32), 256, 0, stream>>>(bufA, Wo0t, x, ctx, mods, out, zc);
    k_p5<<<MTOT / 4, 256, 0, stream>>>(out, zc, mods, ln_g, ln_b, bufA);
    k_gemm_in1<<<dim3(N1 / 128, MTOT / 32), 256, 0, stream>>>(bufA, W1t, bufB, rope);
    k_winattn<<<(MLAT * 8) / 256, 256, 0, stream>>>(bufB, sink, bufA);
    k_conv<<<(MLAT * 512) / 256, 256, 0, stream>>>(bufB, dw_w, dw_b, tmp);
    k_conv_ln<<<MLAT / 4, 256, 0, stream>>>(tmp, bufB, cn_g, cn_b, bufA);
    k_gemm_out<<<dim3(1024 / 128, MLAT / 32), 256, 0, stream>>>(bufA, Wo1t, out, nullptr, mods + 17 * 3072, out, nullptr);
    k_p9<<<MLAT / 4, 256, 0, stream>>>(out, ln_g, ln_b);
}
```

```cpp
#include <hip/hip_runtime.h>
#include <cstdio>
#include <cstdint>
#include <cmath>

typedef unsigned short bf16_t;
typedef short bf16x8 __attribute__((ext_vector_type(8)));
typedef float f32x4 __attribute__((ext_vector_type(4)));
typedef float f32x16 __attribute__((ext_vector_type(16)));
typedef unsigned u32x4 __attribute__((ext_vector_type(4)));
typedef unsigned u32x2 __attribute__((ext_vector_type(2)));

constexpr int NB = 16, NS = 2048, DM = 1024, NC = 256;
constexpr int MLAT = NB * NS, MCTX = NB * NC, MTOT = MLAT + MCTX;
constexpr int N0 = 3584, N1 = 2816, P1W = 2304;
constexpr float LN_EPS = 1e-6f, RMS_EPS = 1e-5f;
constexpr float ALPHA = 1.41421356237f;
constexpr float LOG2E = 1.4426950408889634f;
constexpr float C2 = 0.125f * LOG2E;
constexpr float LAM_INIT0 = 0.2f;

constexpr size_t MiB = 1u << 20;
constexpr size_t WS_CTL = 0;
constexpr size_t WS_MODS = 1 * MiB;
constexpr size_t WS_ROPE = 2 * MiB;
constexpr size_t WS_WSB = 2 * MiB + 65536;
constexpr size_t WS_STATS = 3 * MiB;
constexpr size_t WS_W0T = 4 * MiB;
constexpr size_t WS_WO0T = 12 * MiB;
constexpr size_t WS_W1T = 14 * MiB;
constexpr size_t WS_WO1T = 20 * MiB;
constexpr size_t WS_ZC = 22 * MiB;
constexpr size_t WS_A = 38 * MiB;
constexpr size_t WS_B = 110 * MiB;
constexpr size_t WS_T = 362 * MiB;
constexpr size_t WS_END = 506 * MiB;

__device__ __forceinline__ unsigned f2bf(float f) { unsigned u = __builtin_bit_cast(unsigned, f); return (u + 0x7fffu + ((u >> 16) & 1u)) >> 16; }
__device__ __forceinline__ float bf2f(bf16_t h) { return __builtin_bit_cast(float, (unsigned)h << 16); }
__device__ __forceinline__ unsigned pk2(float lo, float hi) { return f2bf(lo) | (f2bf(hi) << 16); }
__device__ __forceinline__ float silu_f(float v) { return v / (1.f + __expf(-v)); }
__device__ __forceinline__ float sigmoid_f(float v) { return 1.f / (1.f + __expf(-v)); }
__device__ __forceinline__ float gelu_tanh_f(float v) {
    const float u = 0.7978845608028654f * (v + 0.044715f * v * v * v);
    return v / (1.f + __expf(-2.f * u));
}
__device__ __forceinline__ float wave_sum(float v) {
#pragma unroll
    for (int o = 1; o < 64; o <<= 1) v += __shfl_xor(v, o);
    return v;
}
__device__ __forceinline__ int crow(int r, int hi) { return (r & 3) + 8 * (r >> 2) + 4 * hi; }

template <int MODE> __device__ __forceinline__ int w_src_col(int np) {
    if (MODE == 1) {
        if (np < 1024) { const int j = np >> 8, w = np & 255; return w < 128 ? 128 * j + w : 512 + 128 * j + (w - 128); }
        return np;
    }
    return np;
}
template <int MODE> __global__ void k_transpose(const float* __restrict__ W, int N, bf16_t* __restrict__ Wt) {
    __shared__ float tile[32][33];
    const int k0 = blockIdx.x * 32, n0 = blockIdx.y * 32, tx = threadIdx.x & 31, ty = threadIdx.x >> 5;
    for (int i = ty; i < 32; i += 8) { const int np = n0 + tx; tile[i][tx] = W[(size_t)(k0 + i) * N + w_src_col<MODE>(np)]; }
    __syncthreads();
    for (int i = ty; i < 32; i += 8) Wt[(size_t)(n0 + i) * 1024 + k0 + tx] = (bf16_t)f2bf(tile[tx][i]);
}
__global__ void k_mods(const float* __restrict__ c, const float* __restrict__ c_ctx, const float* __restrict__ mod_w, const float* __restrict__ mod_b, float* __restrict__ mods) {
    const int idx = blockIdx.x * blockDim.x + threadIdx.x;
    if (idx >= 2 * 17 * 3072) return;
    const int col = idx % 3072, bp = (idx / 3072) % 17, l = idx / (3072 * 17);
    const float* cv = bp < 16 ? c + bp * 1024 : c_ctx;
    const float* w = mod_w + (size_t)l * 1024 * 3072 + col;
    float acc = 0.f;
    for (int k = 0; k < 1024; ++k) acc += silu_f(cv[k]) * w[(size_t)k * 3072];
    mods[idx] = acc + mod_b[l * 3072 + col];
}
__global__ void k_misc(const float* __restrict__ a_w_s, bf16_t* __restrict__ wsb, float* __restrict__ rope) {
    const int idx = blockIdx.x * blockDim.x + threadIdx.x;
    if (idx < 4 * 128 * 128) wsb[idx] = (bf16_t)f2bf(a_w_s[idx]);
    if (idx < 64 * 16) { const int pos = idx >> 4, j = idx & 15; const float inv = powf(10000.f, -(float)j / 16.f); const float ang = (float)pos * inv;
        rope[idx] = cosf(ang); rope[1024 + idx] = sinf(ang); }
}

template <int MODE> __device__ __forceinline__ void row_op(const float* in, float* outf, bf16_t* outb, const float* g, const float* b, const float* shift, const float* scale, int lane) {
    const f32x4* xr = (const f32x4*)in + lane;
    f32x4 v[4];
#pragma unroll
    for (int j = 0; j < 4; ++j) v[j] = xr[64 * j];
    if (MODE >= 1) {
        float s = 0.f;
#pragma unroll
        for (int j = 0; j < 4; ++j) s += (v[j][0] + v[j][1]) + (v[j][2] + v[j][3]);
        const float mean = wave_sum(s) * (1.f / 1024.f); float s2 = 0.f;
#pragma unroll
        for (int j = 0; j < 4; ++j) { v[j] = v[j] - mean; s2 += (v[j][0] * v[j][0] + v[j][1] * v[j][1]) + (v[j][2] * v[j][2] + v[j][3] * v[j][3]); }
        const float rstd = 1.f / sqrtf(wave_sum(s2) * (1.f / 1024.f) + LN_EPS);
#pragma unroll
        for (int j = 0; j < 4; ++j) { const f32x4 gg = ((const f32x4*)g)[lane + 64 * j], bb = ((const f32x4*)b)[lane + 64 * j]; v[j] = v[j] * rstd * gg + bb; }
        if (outf) {
#pragma unroll
            for (int j = 0; j < 4; ++j) ((f32x4*)outf)[lane + 64 * j] = v[j];
        }
    }
    if (MODE <= 1) {
#pragma unroll
        for (int j = 0; j < 4; ++j) { const f32x4 sc = ((const f32x4*)scale)[lane + 64 * j], sh = ((const f32x4*)shift)[lane + 64 * j];
            const f32x4 u = v[j] * (1.f + sc) + sh; u32x2 w; w[0] = pk2(u[0], u[1]); w[1] = pk2(u[2], u[3]);
            ((u32x2*)outb)[lane + 64 * j] = w; }
    }
}
__global__ void k_p1(const float* __restrict__ x, const float* __restrict__ ctx, const float* __restrict__ mods, bf16_t* __restrict__ u0) {
    const int lane = threadIdx.x & 63; const int row = blockIdx.x * (blockDim.x >> 6) + (threadIdx.x >> 6);
    if (row >= MTOT) return;
    const int bp = row < MLAT ? row / NS : 16; const float* in = row < MLAT ? x + (size_t)row * DM : ctx + (size_t)(row - MLAT) * DM;
    const float* md = mods + (size_t)(0 * 17 + bp) * 3072;
    row_op<0>(in, nullptr, u0 + (size_t)row * DM, nullptr, nullptr, md, md + 1024, lane);
}
__global__ void k_p5(float* __restrict__ out, const float* __restrict__ zc, const float* __restrict__ mods, const float* __restrict__ ln_g, const float* __restrict__ ln_b, bf16_t* __restrict__ u1) {
    const int lane = threadIdx.x & 63; const int row = blockIdx.x * (blockDim.x >> 6) + (threadIdx.x >> 6);
    if (row >= MTOT) return;
    const int bp = row < MLAT ? row / NS : 16; const float* md = mods + (size_t)(1 * 17 + bp) * 3072;
    if (row < MLAT) row_op<1>(out + (size_t)row * DM, out + (size_t)row * DM, u1 + (size_t)row * DM, ln_g, ln_b, md, md + 1024, lane);
    else row_op<1>(zc + (size_t)(row - MLAT) * DM, nullptr, u1 + (size_t)row * DM, ln_g, ln_b, md, md + 1024, lane);
}
__global__ void k_p9(float* __restrict__ out, const float* __restrict__ ln_g, const float* __restrict__ ln_b) {
    const int lane = threadIdx.x & 63; const int row = blockIdx.x * (blockDim.x >> 6) + (threadIdx.x >> 6);
    if (row >= MLAT) return;
    row_op<2>(out + (size_t)row * DM, out + (size_t)row * DM, nullptr, ln_g + 1024, ln_b + 1024, nullptr, nullptr, lane);
}

__device__ __forceinline__ f32x16 mm_tile(const bf16_t* A, const bf16_t* Bt, int m0, int n0, int lane) {
    const int r32 = lane & 31, hi = lane >> 5;
    const bf16_t* a = A + (size_t)(m0 + r32) * 1024 + 8 * hi; const bf16_t* b = Bt + (size_t)(n0 + r32) * 1024 + 8 * hi;
    f32x16 acc = {};
#pragma unroll 4
    for (int k = 0; k < 1024; k += 16) { const bf16x8 fa = *(const bf16x8*)(a + k), fb = *(const bf16x8*)(b + k); acc = __builtin_amdgcn_mfma_f32_32x32x16_bf16(fa, fb, acc, 0, 0, 0); }
    return acc;
}
__device__ __forceinline__ float rope_val(float v, float partner, int d, int t, const float* __restrict__ rope) {
    const int half = d >> 5, i = d & 31, j = i & 15; const int pos = half ? (t & 63) : (t >> 6);
    const float cs = rope[pos * 16 + j], sn = rope[1024 + pos * 16 + j];
    return (i < 16) ? v * cs - partner * sn : v * cs + partner * sn;
}
__global__ void __launch_bounds__(256) k_gemm_in0(const bf16_t* __restrict__ A, const bf16_t* __restrict__ Bt, bf16_t* __restrict__ out, const float* __restrict__ rope) {
    const int lane = threadIdx.x & 63, w = threadIdx.x >> 6, r32 = lane & 31, hi = lane >> 5;
    const int m0 = blockIdx.y * 32, n0 = blockIdx.x * 128 + w * 32;
    const f32x16 acc = mm_tile(A, Bt, m0, n0, lane);
    const int n = n0 + r32;
#pragma unroll
    for (int r = 0; r < 16; ++r) {
        const int row = m0 + crow(r, hi); float v = acc[r];
        const float partner = __shfl_xor(v, 16);
        if (n < 1024) v = gelu_tanh_f(v);
        else if (n < 1536) v = silu_f(v);
        else if (n < 2560) { if (row < MLAT) v = rope_val(v, partner, n & 63, row & (NS - 1), rope); if (n < 2048) v *= C2; }
        else if (n >= 3072) v = silu_f(v);
        out[(size_t)row * N0 + n] = (bf16_t)f2bf(v);
    }
}
__global__ void __launch_bounds__(256) k_gemm_in1(const bf16_t* __restrict__ A, const bf16_t* __restrict__ Bt, bf16_t* __restrict__ out, const float* __restrict__ rope) {
    const int lane = threadIdx.x & 63, w = threadIdx.x >> 6, r32 = lane & 31, hi = lane >> 5;
    const int m0 = blockIdx.y * 32, n0 = blockIdx.x * 128 + w * 32;
    const bool ctxrow = m0 >= MLAT;
    if (ctxrow && (n0 < 2048 || n0 >= 2304)) return;
    if (n0 < 1024) {
        if ((n0 & 255) >= 128) return;
        const f32x16 a = mm_tile(A, Bt, m0, n0, lane), b = mm_tile(A, Bt, m0, n0 + 128, lane);
        const int oc = (n0 >> 8) * 128 + (n0 & 127) + r32;
#pragma unroll
        for (int r = 0; r < 16; ++r) out[(size_t)(m0 + crow(r, hi)) * P1W + oc] = (bf16_t)f2bf(a[r] * sigmoid_f(b[r]));
        return;
    }
    const f32x16 acc = mm_tile(A, Bt, m0, n0, lane);
    const int n = n0 + r32;
#pragma unroll
    for (int r = 0; r < 16; ++r) {
        const int row = m0 + crow(r, hi); float v = acc[r];
        const float partner = __shfl_xor(v, 16);
        if (n < 1536) v = silu_f(v);
        else if (n < 2176) { if (row < MLAT) v = rope_val(v, partner, n & 63, row & (NS - 1), rope); if (n < 2048) v *= C2; }
        else if (n >= 2304) v = silu_f(v);
        out[(size_t)row * P1W + (n - 512)] = (bf16_t)f2bf(v);
    }
}
__global__ void __launch_bounds__(256) k_gemm_out(const bf16_t* __restrict__ A, const bf16_t* __restrict__ Bt, const float* hlat, const float* __restrict__ hctx,
                                                  const float* __restrict__ mods_l, float* zlat, float* __restrict__ zctx) {
    const int lane = threadIdx.x & 63, w = threadIdx.x >> 6, r32 = lane & 31, hi = lane >> 5;
    const int m0 = blockIdx.y * 32, n0 = blockIdx.x * 128 + w * 32;
    const f32x16 acc = mm_tile(A, Bt, m0, n0, lane);
    const int n = n0 + r32;
#pragma unroll
    for (int r = 0; r < 16; ++r) {
        const int row = m0 + crow(r, hi);
        if (row < MLAT) { const float gate = mods_l[(size_t)(row / NS) * 3072 + 2048 + n]; const size_t o = (size_t)row * DM + n; zlat[o] = ALPHA * hlat[o] + gate * acc[r]; }
        else { const float gate = mods_l[(size_t)16 * 3072 + 2048 + n]; const size_t o = (size_t)(row - MLAT) * DM + n; zctx[o] = ALPHA * hctx[o] + gate * acc[r]; }
    }
}

__global__ void __launch_bounds__(256) k_diffattn(const bf16_t* __restrict__ P, float* __restrict__ tmp) {
    const int idx = blockIdx.x * blockDim.x + threadIdx.x;
    const int row = idx % MTOT, hc = idx / MTOT; if (hc >= 8) return;
    const int h = hc >> 1, c = hc & 1;
    const bool lat = row < MLAT; const int b = lat ? row / NS : (row - MLAT) / NC;
    float q[64];
    { const bf16_t* qp = P + (size_t)row * N0 + 1536 + h * 128 + c * 64;
#pragma unroll
      for (int d = 0; d < 64; ++d) q[d] = bf2f(qp[d]); }
    float o[128];
#pragma unroll
    for (int d = 0; d < 128; ++d) o[d] = 0.f;
    float m = -1e30f, l = 0.f;
    const int nk = lat ? NC + NS : NC;
    for (int j = 0; j < nk; ++j) {
        const int krow = j < NC ? MLAT + b * NC + j : b * NS + (j - NC);
        const bf16_t* kp = P + (size_t)krow * N0 + 2048 + h * 128 + c * 64; const bf16_t* vp = P + (size_t)krow * N0 + 2560 + h * 128;
        float s = 0.f;
#pragma unroll
        for (int d8 = 0; d8 < 8; ++d8) { const bf16x8 kk = *(const bf16x8*)(kp + d8 * 8);
#pragma unroll
            for (int e = 0; e < 8; ++e) s += q[d8 * 8 + e] * bf2f((bf16_t)kk[e]); }
        const float mn = fmaxf(m, s), f = exp2f(m - mn), p = exp2f(s - mn);
        l = l * f + p; m = mn;
#pragma unroll
        for (int d8 = 0; d8 < 16; ++d8) { const bf16x8 vv = *(const bf16x8*)(vp + d8 * 8);
#pragma unroll
            for (int e = 0; e < 8; ++e) o[d8 * 8 + e] = o[d8 * 8 + e] * f + p * bf2f((bf16_t)vv[e]); }
    }
    const float il = 1.f / l; float* op = tmp + ((size_t)row * 8 + hc) * 128;
#pragma unroll
    for (int d = 0; d < 128; ++d) op[d] = o[d] * il;
}
__global__ void k_diffcombine(const float* __restrict__ tmp, const bf16_t* __restrict__ P, const float* __restrict__ lq1, const float* __restrict__ lk1, const float* __restrict__ lq2,
                              const float* __restrict__ lk2, const float* __restrict__ subg, bf16_t* __restrict__ mix) {
    const int lane = threadIdx.x & 63; const int wv = blockIdx.x * (blockDim.x >> 6) + (threadIdx.x >> 6);
    if (wv >= MTOT * 4) return;
    const int row = wv >> 2, h = wv & 3;
    const float lam = __expf(wave_sum(lq1[lane] * lk1[lane])) - __expf(wave_sum(lq2[lane] * lk2[lane])) + LAM_INIT0;
    const float* o1 = tmp + ((size_t)row * 8 + h * 2) * 128; const float* o2 = o1 + 128;
    const float a0 = o1[lane] - lam * o2[lane], a1 = o1[lane + 64] - lam * o2[lane + 64];
    const float r = 1.f / sqrtf(wave_sum(a0 * a0 + a1 * a1) * (1.f / 128.f) + RMS_EPS);
    const bf16_t* bg = P + (size_t)row * N0 + 3072 + h * 128; bf16_t* mo = mix + (size_t)row * DM + 512 + h * 128;
    mo[lane] = (bf16_t)f2bf(a0 * r * subg[lane] * (1.f - LAM_INIT0) * bf2f(bg[lane]));
    mo[lane + 64] = (bf16_t)f2bf(a1 * r * subg[lane + 64] * (1.f - LAM_INIT0) * bf2f(bg[lane + 64]));
}
__global__ void k_gmlp_stats(const bf16_t* __restrict__ P, float* __restrict__ stats) {
    const int lane = threadIdx.x & 63; const int row = blockIdx.x * (blockDim.x >> 6) + (threadIdx.x >> 6);
    if (row >= MTOT) return;
    const bf16x8 v = *(const bf16x8*)(P + (size_t)row * N0 + 512 + lane * 8);
    float f[8], s = 0.f;
#pragma unroll
    for (int e = 0; e < 8; ++e) { f[e] = bf2f((bf16_t)v[e]); s += f[e]; }
    const float mean = wave_sum(s) * (1.f / 512.f); float s2 = 0.f;
#pragma unroll
    for (int e = 0; e < 8; ++e) { const float d = f[e] - mean; s2 += d * d; }
    const float rstd = 1.f / sqrtf(wave_sum(s2) * (1.f / 512.f) + LN_EPS);
    if (lane == 0) { stats[2 * row] = mean; stats[2 * row + 1] = rstd; }
}
__global__ void __launch_bounds__(256) k_gmlp(const bf16_t* __restrict__ P, const float* __restrict__ stats, const float* __restrict__ a_w_s, const float* __restrict__ a_b_s,
                                             const float* __restrict__ ng, const float* __restrict__ nb, bf16_t* __restrict__ mix) {
    const int idx = blockIdx.x * blockDim.x + threadIdx.x; const int col = idx & 511, row = idx >> 9; if (row >= MTOT) return;
    const int g = col >> 7, p = row & 127, row0 = row - p;
    const float* w = a_w_s + ((size_t)g * 128 + p) * 128; const float gg = ng[col], bb = nb[col];
    float acc = 0.f;
    for (int q = 0; q < 128; ++q) { const int rq = row0 + q; const float v = bf2f(P[(size_t)rq * N0 + 512 + col]); acc += w[q] * ((v - stats[2 * rq]) * stats[2 * rq + 1] * gg + bb); }
    acc += a_b_s[g * 128 + p];
    const float u = bf2f(P[(size_t)row * N0 + col]), ag = bf2f(P[(size_t)row * N0 + 1024 + col]);
    mix[(size_t)row * DM + col] = (bf16_t)f2bf(u * acc * ag);
}
__global__ void __launch_bounds__(256) k_winattn(const bf16_t* __restrict__ P, const float* __restrict__ sink, bf16_t* __restrict__ mix) {
    const int idx = blockIdx.x * blockDim.x + threadIdx.x; const int row = idx % MLAT, h = idx / MLAT; if (h >= 8) return;
    const int b = row / NS, t = row % NS, kvh = h >> 2;
    float q[64];
    { const bf16_t* qp = P + (size_t)row * P1W + 1024 + h * 64;
#pragma unroll
      for (int d = 0; d < 64; ++d) q[d] = bf2f(qp[d]); }
    float o[64];
#pragma unroll
    for (int d = 0; d < 64; ++d) o[d] = 0.f;
    float m = sink[h] * LOG2E, l = 1.f;
    const int lo = t - 128 < 0 ? 0 : t - 128, hi = t + 128 > NS - 1 ? NS - 1 : t + 128;
    const int nk = NC + (hi - lo + 1);
    for (int j = 0; j < nk; ++j) {
        const int krow = j < NC ? MLAT + b * NC + j : b * NS + lo + (j - NC);
        const bf16_t* kp = P + (size_t)krow * P1W + 1536 + kvh * 64; const bf16_t* vp = P + (size_t)krow * P1W + 1664 + kvh * 64;
        float s = 0.f;
#pragma unroll
        for (int d8 = 0; d8 < 8; ++d8) { const bf16x8 kk = *(const bf16x8*)(kp + d8 * 8);
#pragma unroll
            for (int e = 0; e < 8; ++e) s += q[d8 * 8 + e] * bf2f((bf16_t)kk[e]); }
        const float mn = fmaxf(m, s), f = exp2f(m - mn), p = exp2f(s - mn);
        l = l * f + p; m = mn;
#pragma unroll
        for (int d8 = 0; d8 < 8; ++d8) { const bf16x8 vv = *(const bf16x8*)(vp + d8 * 8);
#pragma unroll
            for (int e = 0; e < 8; ++e) o[d8 * 8 + e] = o[d8 * 8 + e] * f + p * bf2f((bf16_t)vv[e]); }
    }
    const float il = 1.f / l; const bf16_t* dg = P + (size_t)row * P1W + 1792 + h * 64; bf16_t* mo = mix + (size_t)row * DM + 512 + h * 64;
#pragma unroll
    for (int d = 0; d < 64; ++d) mo[d] = (bf16_t)f2bf(o[d] * il * bf2f(dg[d]));
}
__global__ void __launch_bounds__(256) k_conv(const bf16_t* __restrict__ P, const float* __restrict__ dw_w, const float* __restrict__ dw_b, float* __restrict__ ytmp) {
    const int idx = blockIdx.x * blockDim.x + threadIdx.x; const int c = idx & 511, row = idx >> 9; if (row >= MLAT) return;
    const int t = row % NS; float acc = dw_b[c];
    for (int k = 0; k < 31; ++k) { const int tt = t + k - 15; if (tt >= 0 && tt < NS) acc += dw_w[k * 512 + c] * bf2f(P[(size_t)(row + k - 15) * P1W + c]); }
    ytmp[(size_t)row * 512 + c] = acc;
}
__global__ void k_conv_ln(const float* __restrict__ ytmp, const bf16_t* __restrict__ P, const float* __restrict__ g, const float* __restrict__ b, bf16_t* __restrict__ mix) {
    const int lane = threadIdx.x & 63; const int row = blockIdx.x * (blockDim.x >> 6) + (threadIdx.x >> 6);
    if (row >= MLAT) return;
    float f[8], s = 0.f;
#pragma unroll
    for (int e = 0; e < 8; ++e) { f[e] = ytmp[(size_t)row * 512 + lane * 8 + e]; s += f[e]; }
    const float mean = wave_sum(s) * (1.f / 512.f); float s2 = 0.f;
#pragma unroll
    for (int e = 0; e < 8; ++e) { f[e] -= mean; s2 += f[e] * f[e]; }
    const float rstd = 1.f / sqrtf(wave_sum(s2) * (1.f / 512.f) + LN_EPS);
#pragma unroll
    for (int e = 0; e < 8; ++e) { const int c = lane * 8 + e; const float y = f[e] * rstd * g[c] + b[c];
        mix[(size_t)row * DM + c] = (bf16_t)f2bf(silu_f(y) * bf2f(P[(size_t)row * P1W + 512 + c])); }
}

namespace pg8 {
#define PG8_LAS __attribute__((address_space(3)))
typedef unsigned short bf16_t;
typedef short bf16x8 __attribute__((ext_vector_type(8)));
typedef float f32x4 __attribute__((ext_vector_type(4)));
typedef unsigned u32x4 __attribute__((ext_vector_type(4)));
constexpr int BM = 256, BK = 64, HALF = 128, HTB = HALF * BK * 2  , STAGE_BYTES = 8 * HTB, NXCD = 8, WGM = 8;

__host__ __device__ __forceinline__ int lds_byte(int r, int c) { const int st = (r >> 4) * 2 + (c >> 5), rr = r & 15, cc = c & 31, ob = rr * 64 + cc * 2; return st * 1024 + (ob ^ (((ob >> 9) & 1) << 5)); }
__host__ __device__ __forceinline__ void stage_rc(int b, int& R, int& C) { const int st = b / 1024, sb = b % 1024, swz = sb ^ (((sb >> 9) & 1) << 5); R = (st >> 1) * 16 + swz / 64; C = (st & 1) * 32 + (swz % 64) / 2; }
__host__ __device__ __forceinline__ int perm32(int rho) { const int n = rho >> 4, i = rho & 15; return 8 * (i >> 2) + 4 * n + (i & 3); }

struct Unit { int pm, pn; };
struct Gemm { const bf16_t* A; const bf16_t* Bt; int M, N, K; };

struct StaticOrder {
    int nM, nN, nwg, G, c;
    __host__ __device__ void init(int M, int N, int G_, int c_) { nM = M / BM; nN = N / BM; nwg = nM * nN; G = G_; c = c_; }
    __host__ __device__ bool next(int i, Unit& u) const {
        const long L = (long)i * G + c; if (L >= nwg) return false;
        int wgid = (int)L; { const int q = nwg / NXCD, r = nwg % NXCD, xcd = wgid % NXCD, off = wgid / NXCD; wgid = (xcd < r ? xcd * (q + 1) : r * (q + 1) + (xcd - r) * q) + off; }
        const int nig = WGM * nN, gid = wgid / nig, fm = gid * WGM, gsz = (nM - fm) < WGM ? (nM - fm) : WGM;
        u.pm = fm + ((wgid % nig) % gsz); u.pn = (wgid % nig) / gsz; return true;
    }
    __device__ __forceinline__ void a_ready(const Unit&) const {}
    __device__ __forceinline__ void done(const Unit&) const {}
};

__device__ __forceinline__ unsigned cvt_pk_bf16(float lo, float hi) { unsigned r; asm volatile("v_cvt_pk_bf16_f32 %0, %1, %2" : "=v"(r) : "v"(lo), "v"(hi)); return r; }
typedef float f32x2 __attribute__((ext_vector_type(2)));
template <class Epi, class Sched, bool ALIGN_EPI = false, bool SP2 = false>
__device__ __forceinline__ void gemm_phase(PG8_LAS unsigned char* lds, const Gemm g, const Sched& S, const Epi& E) {
    const int tid = threadIdx.x, wid = __builtin_amdgcn_readfirstlane(tid >> 6), lane = tid & 63, wr = wid >> 2, wc = wid & 3, fr = lane & 15, fq = lane >> 4;
    const int K = g.K, nt = K / BK;
    unsigned voffA[2], voffB[2];
#pragma unroll
    for (int i = 0; i < 2; ++i) { int R, C; stage_rc(tid * 16 + i * 8192, R, C); const int Rb = Epi::PERM ? ((R & ~31) + perm32(R & 31)) : R;
        voffA[i] = (unsigned)(R * K + C) * 2u; voffB[i] = (unsigned)(Rb * K + C) * 2u; }
    const size_t kstep = (size_t)(BK * 2);
    const size_t hstep = (size_t)HALF * K * 2;
    const size_t tstep = 2 * hstep;
    const unsigned ldsw = (unsigned)wid * 1024u;
    const int aoff = lds_byte(wr * 64 + fr, fq * 8), boff = lds_byte(wc * 32 + fr, fq * 8);
#define PG8_SA(b, h) (((b) * 2 + (h)) * HTB)
#define PG8_SB(b, h) ((4 + (b) * 2 + (h)) * HTB)
#define PG8_STAGE(bufoff, gbase, voff) do { _Pragma("unroll") for (int _i = 0; _i < 2; ++_i) \
        __builtin_amdgcn_global_load_lds((const unsigned*)((const char*)(gbase) + (voff)[_i]), (PG8_LAS unsigned*)(lds + (bufoff) + ldsw + _i * 8192), 16, 0, 0); } while (0)
#define PG8_LDA(dst, b, h) do { _Pragma("unroll") for (int m = 0; m < 4; ++m) _Pragma("unroll") for (int k = 0; k < 2; ++k) dst[m][k] = *(const PG8_LAS bf16x8*)(lds + PG8_SA(b, h) + aoff + m * 2048 + k * 1024); } while (0)
#define PG8_LDB(dst, b, h) do { _Pragma("unroll") for (int n = 0; n < 2; ++n) _Pragma("unroll") for (int k = 0; k < 2; ++k) dst[n][k] = *(const PG8_LAS bf16x8*)(lds + PG8_SB(b, h) + boff + n * 2048 + k * 1024); } while (0)
#define PG8_MMA(ai, bj, At, Bt) do { __builtin_amdgcn_s_setprio(1); _Pragma("unroll") for (int m = 0; m < 4; ++m) _Pragma("unroll") for (int n = 0; n < 2; ++n) _Pragma("unroll") for (int k = 0; k < 2; ++k) \
        acc[ai][bj][m][n] = __builtin_amdgcn_mfma_f32_16x16x32_bf16(Bt[n][k], At[m][k], acc[ai][bj][m][n], 0, 0, 0); __builtin_amdgcn_s_setprio(0); } while (0)
#define PG8_WAIT_V(n) asm volatile("s_waitcnt vmcnt(" #n ")" ::: "memory")
#define PG8_WAIT_L(n) asm volatile("s_waitcnt lgkmcnt(" #n ")" ::: "memory")
#define PG8_BAR __builtin_amdgcn_s_barrier()
#define PG8_SCHED __builtin_amdgcn_sched_barrier(0)
    Unit cur, nxt; int ui = 0;
    if (!S.next(0, cur)) return;
    f32x4 acc[2][2][4][2];
#pragma unroll
    for (int a = 0; a < 2; ++a)
#pragma unroll
        for (int b = 0; b < 2; ++b)
#pragma unroll
            for (int m = 0; m < 4; ++m)
#pragma unroll
                for (int n = 0; n < 2; ++n) acc[a][b][m][n] = (f32x4){0.f, 0.f, 0.f, 0.f};
    bf16x8 At[4][2], B0[2][2], B1[2][2];
    const char* cA = (const char*)g.A + (size_t)cur.pm * tstep; const char* cB = (const char*)g.Bt + (size_t)cur.pn * tstep;
    S.a_ready(cur);
    if constexpr (SP2) {
        PG8_STAGE(PG8_SB(0, 0), cB, voffB); PG8_STAGE(PG8_SB(0, 1), cB + hstep, voffB); PG8_STAGE(PG8_SA(0, 0), cA, voffA); PG8_STAGE(PG8_SA(0, 1), cA + hstep, voffA);
        if (wr == 1) PG8_BAR;
        PG8_WAIT_V(2); PG8_BAR;
        PG8_STAGE(PG8_SB(1, 0), cB + kstep, voffB); PG8_STAGE(PG8_SA(1, 0), cA + kstep, voffA); PG8_STAGE(PG8_SB(1, 1), cB + hstep + kstep, voffB);
        PG8_WAIT_V(6); PG8_BAR;
    } else {
        PG8_STAGE(PG8_SB(0, 0), cB, voffB); PG8_STAGE(PG8_SA(0, 0), cA, voffA); PG8_STAGE(PG8_SB(0, 1), cB + hstep, voffB); PG8_STAGE(PG8_SA(0, 1), cA + hstep, voffA);
        if (wr == 1) PG8_BAR;
        PG8_WAIT_V(4); PG8_BAR;
        PG8_STAGE(PG8_SB(1, 0), cB + kstep, voffB); PG8_STAGE(PG8_SA(1, 0), cA + kstep, voffA); PG8_STAGE(PG8_SB(1, 1), cB + hstep + kstep, voffB);
        PG8_WAIT_V(6); PG8_BAR;
    }
    for (;;) {
        const bool has_next = S.next(ui + 1, nxt);
        const char* nA = has_next ? (const char*)g.A + (size_t)nxt.pm * tstep : cA; const char* nB = has_next ? (const char*)g.Bt + (size_t)nxt.pn * tstep : cB;
        for (int t = 0; t < nt; t += 2) {
            const bool last = (t == nt - 2);
            const char* a1 = cA + (size_t)(t + 1) * kstep;
            const char* a2 = last ? nA : cA + (size_t)(t + 2) * kstep; const char* b2 = last ? nB : cB + (size_t)(t + 2) * kstep;
            const char* a3 = a2 + kstep; const char* b3 = b2 + kstep;
            if (last && has_next) S.a_ready(nxt);
            if constexpr (SP2) {
            PG8_LDB(B0, 0, 0); PG8_LDB(B1, 0, 1); PG8_SCHED; PG8_LDA(At, 0, 0); PG8_STAGE(PG8_SA(1, 1), a1 + hstep, voffA);
            PG8_WAIT_V(8); PG8_WAIT_L(0); PG8_BAR; PG8_MMA(0, 0, At, B0); PG8_MMA(0, 1, At, B1); PG8_BAR; PG8_SCHED;
            PG8_LDA(At, 0, 1); PG8_STAGE(PG8_SB(0, 0), b2, voffB); PG8_STAGE(PG8_SB(0, 1), b2 + hstep, voffB); PG8_STAGE(PG8_SA(0, 0), a2, voffA);
            PG8_WAIT_V(8); PG8_WAIT_L(0); PG8_BAR; PG8_MMA(1, 0, At, B0); PG8_MMA(1, 1, At, B1); PG8_BAR; PG8_SCHED;
            PG8_LDB(B0, 1, 0); PG8_LDB(B1, 1, 1); PG8_SCHED; PG8_LDA(At, 1, 0); PG8_STAGE(PG8_SA(0, 1), a2 + hstep, voffA);
            PG8_WAIT_V(8); PG8_WAIT_L(0); PG8_BAR; PG8_MMA(0, 0, At, B0); PG8_MMA(0, 1, At, B1); PG8_BAR; PG8_SCHED;
            PG8_LDA(At, 1, 1); PG8_STAGE(PG8_SB(1, 0), b3, voffB); PG8_STAGE(PG8_SB(1, 1), b3 + hstep, voffB); PG8_STAGE(PG8_SA(1, 0), a3, voffA);
            PG8_WAIT_V(8); PG8_WAIT_L(0); PG8_BAR; PG8_MMA(1, 0, At, B0); PG8_MMA(1, 1, At, B1); PG8_BAR; PG8_SCHED;
            } else {
            PG8_LDB(B0, 0, 0); PG8_SCHED; PG8_LDA(At, 0, 0); PG8_STAGE(PG8_SA(1, 1), a1 + hstep, voffA);
            PG8_WAIT_L(8); PG8_BAR; PG8_WAIT_L(0); PG8_MMA(0, 0, At, B0); PG8_BAR; PG8_SCHED;
            PG8_LDB(B1, 0, 1); PG8_STAGE(PG8_SB(0, 0), b2, voffB);
            PG8_BAR; PG8_WAIT_L(0); PG8_MMA(0, 1, At, B1); PG8_BAR;
            PG8_LDA(At, 0, 1); PG8_STAGE(PG8_SA(0, 0), a2, voffA);
            PG8_BAR; PG8_WAIT_L(0); PG8_MMA(1, 0, At, B0); PG8_BAR; PG8_SCHED;
            PG8_STAGE(PG8_SB(0, 1), b2 + hstep, voffB);
            PG8_WAIT_V(6); PG8_BAR; PG8_MMA(1, 1, At, B1); PG8_BAR;
            PG8_LDB(B0, 1, 0); PG8_SCHED; PG8_LDA(At, 1, 0); PG8_STAGE(PG8_SA(0, 1), a2 + hstep, voffA);
            PG8_WAIT_L(8); PG8_BAR; PG8_WAIT_L(0); PG8_MMA(0, 0, At, B0); PG8_BAR; PG8_SCHED;
            PG8_LDB(B1, 1, 1); PG8_STAGE(PG8_SB(1, 0), b3, voffB);
            PG8_BAR; PG8_WAIT_L(0); PG8_MMA(0, 1, At, B1); PG8_BAR;
            PG8_LDA(At, 1, 1); PG8_STAGE(PG8_SA(1, 0), a3, voffA);
            PG8_BAR; PG8_WAIT_L(0); PG8_MMA(1, 0, At, B0); PG8_BAR; PG8_SCHED;
            PG8_STAGE(PG8_SB(1, 1), b3 + hstep, voffB);
            PG8_WAIT_V(6); PG8_BAR; PG8_MMA(1, 1, At, B1); PG8_BAR;
            }
        }
        if constexpr (ALIGN_EPI) { if (wr == 0) PG8_BAR; }
        if constexpr (!Epi::AFTER_DRAIN) { E(acc, cur, wr, wc, fr, fq); S.done(cur); }
        if (!has_next) break;
#pragma unroll
        for (int a = 0; a < 2; ++a)
#pragma unroll
            for (int b = 0; b < 2; ++b)
#pragma unroll
                for (int m = 0; m < 4; ++m)
#pragma unroll
                    for (int n = 0; n < 2; ++n) acc[a][b][m][n] = (f32x4){0.f, 0.f, 0.f, 0.f};
        cur = nxt; cA = nA; cB = nB; ++ui;
        if constexpr (ALIGN_EPI) { if (wr == 1) PG8_BAR; }
    }
    PG8_WAIT_V(0);
    if constexpr (!ALIGN_EPI) { if (wr == 0) PG8_BAR; }
    PG8_BAR;
    if constexpr (Epi::AFTER_DRAIN) { E.fused(acc, cur, wr, wc, fr, fq, lds, wid, lane); S.done(cur); }
#undef PG8_SA
#undef PG8_SB
#undef PG8_STAGE
#undef PG8_LDA
#undef PG8_LDB
#undef PG8_MMA
#undef PG8_WAIT_V
#undef PG8_WAIT_L
#undef PG8_BAR
#undef PG8_SCHED
}
}
#define GAS __attribute__((address_space(1)))
#define LAS __attribute__((address_space(3)))
typedef GAS unsigned gu32;
typedef GAS unsigned long long gu64;
#define RLX_AGENT __ATOMIC_RELAXED, __HIP_MEMORY_SCOPE_AGENT
#define LDS_WAIT() asm volatile("s_waitcnt lgkmcnt(0)" ::: "memory")
#define VM_WAIT() asm volatile("s_waitcnt vmcnt(0)" ::: "memory")

#define XB_TMO      128
#define XB_XCNT(j)  (256  + 64 * (j))
#define XB_XSUB(j)  (1280 + 64 * (j))
#define XB_XGEN(j)  (2304 + 64 * (j))
#define XB_TOP      3328
#define XB_TOPGEN   3392
#define XCD_BAR_WORDS 3456
#define XB_SPIN_CAP (1u << 18)

__device__ __forceinline__ unsigned xb_ld(unsigned* p)              { return __hip_atomic_load(p, __ATOMIC_RELAXED, __HIP_MEMORY_SCOPE_AGENT); }
__device__ __forceinline__ unsigned xb_add(unsigned* p, unsigned v) { return __hip_atomic_fetch_add(p, v, __ATOMIC_RELAXED, __HIP_MEMORY_SCOPE_AGENT); }
__device__ __forceinline__ unsigned xb_xcc_id() { return (unsigned)__builtin_amdgcn_s_getreg((3 << 11) | 20) & 0xFu; }
#define XB_SPIN(cond, bar) do { unsigned _sp = 0; while (cond) { __builtin_amdgcn_s_sleep(1); \
    if ((++_sp & 255u) == 0u) { if (xb_ld(&(bar)[XB_TMO])) break; if (_sp > XB_SPIN_CAP) { atomicAdd(&(bar)[XB_TMO], 1u); break; } } } } while (0)

struct XcdBarrier {
    unsigned* bar; unsigned x;
    volatile LAS unsigned* st;
};

__device__ __forceinline__ XcdBarrier xcd_barrier_post(unsigned* bar, volatile LAS unsigned* st) {
    XcdBarrier b; b.bar = bar; b.x = xb_xcc_id(); b.st = st;
    if (threadIdx.x == 0) (void)xb_add(&bar[XB_XCNT(b.x)], 1u);
    return b;
}
__device__ __forceinline__ void xcd_barrier_complete(unsigned* bar, unsigned x, unsigned& nloc, unsigned& nx) {
    const unsigned G = gridDim.x * gridDim.y * gridDim.z;
    unsigned sum, cnt, mine, sp = 0u;
    for (;;) {
        sum = 0u; cnt = 0u; mine = 0u;
#pragma unroll
        for (unsigned j = 0; j < 16; ++j) { const unsigned c = xb_ld(&bar[XB_XCNT(j)]); sum += c; cnt += (c > 0u) ? 1u : 0u; mine = (j == x) ? c : mine; }
        if (sum == G) break;
        __builtin_amdgcn_s_sleep(1);
        if ((++sp & 255u) == 0u) { if (xb_ld(&bar[XB_TMO])) break; if (sp > XB_SPIN_CAP) { atomicAdd(&bar[XB_TMO], 1u); break; } }
    }
    nloc = mine > 0u ? mine : 1u; nx = cnt > 0u ? cnt : 1u;
}

__device__ __forceinline__ void xcd_barrier(const XcdBarrier& b) {
    asm volatile("s_waitcnt vmcnt(0)" ::: "memory");
    __syncthreads();
    if (threadIdx.x == 0) {
        unsigned* bar = b.bar;
        __builtin_amdgcn_s_waitcnt(0);
        unsigned nloc = b.st[0], nx = b.st[1];
        if (nloc == 0u) { xcd_barrier_complete(bar, b.x, nloc, nx); b.st[0] = nloc; b.st[1] = nx; }
        const unsigned old = xb_add(&bar[XB_XSUB(b.x)], 1u);
        const unsigned gen = old / nloc;
        if (old + 1u == (gen + 1u) * nloc) {
            __builtin_amdgcn_fence(__ATOMIC_RELEASE, "agent");
            asm volatile("s_waitcnt vmcnt(0)" ::: "memory");
            const unsigned og = xb_add(&bar[XB_TOP], 1u);
            const unsigned tg = og / nx;
            if (og + 1u == (tg + 1u) * nx) xb_add(&bar[XB_TOPGEN], 1u);
            else XB_SPIN(xb_ld(&bar[XB_TOPGEN]) == tg, bar);
            __builtin_amdgcn_fence(__ATOMIC_ACQUIRE, "agent");
            xb_add(&bar[XB_XGEN(b.x)], 1u);
            asm volatile("s_waitcnt vmcnt(0)" ::: "memory");
        } else {
            XB_SPIN(xb_ld(&bar[XB_XGEN(b.x)]) == gen, bar);
            __builtin_amdgcn_fence(__ATOMIC_ACQUIRE, "agent");
            asm volatile("s_waitcnt vmcnt(0)" ::: "memory");
        }
    }
    __syncthreads();
}
constexpr int SCR_BYTES = 143360, ROPE_OFF = SCR_BYTES, MISC_OFF = ROPE_OFF + 8192, LDS_BYTES = MISC_OFF + 256;
constexpr int CW_TMO = 0, CW_BAR = 4096;
typedef LAS unsigned char* ldsp_t;
typedef LAS const char* lds_cptr;
typedef short s16x4 __attribute__((ext_vector_type(4)));
typedef short v4i16_t __attribute__((ext_vector_type(4)));
typedef float f32x2_t __attribute__((ext_vector_type(2)));
typedef __bf16 bf16x2_t __attribute__((ext_vector_type(2)));
__device__ __forceinline__ unsigned cvtpk(float lo, float hi) { f32x2_t v = {lo, hi}; bf16x2_t b = __builtin_convertvector(v, bf16x2_t); return __builtin_bit_cast(unsigned, b); }
__device__ __forceinline__ float bflo(unsigned w) { return __builtin_bit_cast(float, w << 16); }
__device__ __forceinline__ float bfhi(unsigned w) { return __builtin_bit_cast(float, w & 0xffff0000u); }
__device__ __forceinline__ float lane32_partner(float v) {
    auto rr = __builtin_amdgcn_permlane32_swap(__float_as_uint(v), __float_as_uint(v), false, false);
    return (threadIdx.x & 32) ? __uint_as_float(rr[0]) : __uint_as_float(rr[1]);
}

struct EpiAct {
    __device__ static __forceinline__ void rope8(pg8::f32x4& v0, pg8::f32x4& v1, int t, int wc, int fq, const LAS float* rope, float scale) {
        const int pos = (wc & 1) ? (t & 63) : (t >> 6); const LAS float* cp = rope + pos * 16 + 8 * (fq & 1);
        const pg8::f32x4 c0 = *(const LAS pg8::f32x4*)cp, c1 = *(const LAS pg8::f32x4*)(cp + 4), s0 = *(const LAS pg8::f32x4*)(cp + 1024), s1 = *(const LAS pg8::f32x4*)(cp + 1028);
        const float sg = (fq < 2) ? -scale : scale;
#pragma unroll
        for (int e = 0; e < 4; ++e) { const float p0 = lane32_partner(v0[e]), p1 = lane32_partner(v1[e]);
            v0[e] = v0[e] * (c0[e] * scale) + p0 * (s0[e] * sg); v1[e] = v1[e] * (c1[e] * scale) + p1 * (s1[e] * sg); }
    }
    __device__ static __forceinline__ void store8(bf16_t* p, const pg8::f32x4& v0, const pg8::f32x4& v1) {
        pg8::u32x4 w; w.x = cvtpk(v0[0], v0[1]); w.y = cvtpk(v0[2], v0[3]); w.z = cvtpk(v1[0], v1[1]); w.w = cvtpk(v1[2], v1[3]); *(pg8::u32x4*)p = w;
    }
};
struct Epi0 {
    static constexpr bool PERM = true, AFTER_DRAIN = false;
    bf16_t* O; const LAS float* rope;
    __device__ __forceinline__ void operator()(const pg8::f32x4 (&acc)[2][2][4][2], const pg8::Unit& u, int wr, int wc, int fr, int fq) const {
        const int pn = u.pn; const int mode = pn < 4 ? 0 : pn < 6 ? 1 : pn < 10 ? 2 : pn < 12 ? 3 : 1;
        const bool lat = u.pm < MLAT / 256; const float qs = pn < 8 ? C2 : 1.f;
        const int row0 = u.pm * 256 + wr * 64 + fr, col0 = pn * 256 + wc * 32 + 8 * fq;
#pragma unroll
        for (int ai = 0; ai < 2; ++ai)
#pragma unroll
            for (int m = 0; m < 4; ++m) { const int row = row0 + ai * 128 + m * 16; bf16_t* rowp = O + (size_t)row * N0 + col0;
#pragma unroll
                for (int bj = 0; bj < 2; ++bj) { pg8::f32x4 v0 = acc[ai][bj][m][0], v1 = acc[ai][bj][m][1];
                    if (mode == 0) {
#pragma unroll
                        for (int e = 0; e < 4; ++e) { v0[e] = gelu_tanh_f(v0[e]); v1[e] = gelu_tanh_f(v1[e]); } }
                    else if (mode == 1) {
#pragma unroll
                        for (int e = 0; e < 4; ++e) { v0[e] = silu_f(v0[e]); v1[e] = silu_f(v1[e]); } }
                    else if (mode == 2) { if (lat) EpiAct::rope8(v0, v1, row & (NS - 1), wc, fq, rope, qs); else { v0 = v0 * qs; v1 = v1 * qs; } }
                    EpiAct::store8(rowp + bj * 128, v0, v1); } }
    }
};
struct Epi1 {
    static constexpr bool PERM = true, AFTER_DRAIN = false;
    bf16_t* O; const LAS float* rope;
    __device__ __forceinline__ void operator()(const pg8::f32x4 (&acc)[2][2][4][2], const pg8::Unit& u, int wr, int wc, int fr, int fq) const {
        const int pn = u.pn; const bool lat = u.pm < MLAT / 256;
        const int row0 = u.pm * 256 + wr * 64 + fr;
        if (pn < 4) {
            const int col0 = pn * 128 + wc * 32 + 8 * fq;
#pragma unroll
            for (int ai = 0; ai < 2; ++ai)
#pragma unroll
                for (int m = 0; m < 4; ++m) { const int row = row0 + ai * 128 + m * 16; pg8::f32x4 v0, v1;
#pragma unroll
                    for (int e = 0; e < 4; ++e) { v0[e] = acc[ai][0][m][0][e] * sigmoid_f(acc[ai][1][m][0][e]); v1[e] = acc[ai][0][m][1][e] * sigmoid_f(acc[ai][1][m][1][e]); }
                    EpiAct::store8(O + (size_t)row * P1W + col0, v0, v1); }
            return;
        }
        const int col0 = pn * 256 - 512 + wc * 32 + 8 * fq;
#pragma unroll
        for (int ai = 0; ai < 2; ++ai)
#pragma unroll
            for (int m = 0; m < 4; ++m) { const int row = row0 + ai * 128 + m * 16; bf16_t* rowp = O + (size_t)row * P1W + col0;
#pragma unroll
                for (int bj = 0; bj < 2; ++bj) { pg8::f32x4 v0 = acc[ai][bj][m][0], v1 = acc[ai][bj][m][1];
                    const int mode = (pn < 6 || pn > 8) ? 1 : (pn < 8) ? 2 : (bj == 0 ? 2 : 3);
                    if (mode == 1) {
#pragma unroll
                        for (int e = 0; e < 4; ++e) { v0[e] = silu_f(v0[e]); v1[e] = silu_f(v1[e]); } }
                    else if (mode == 2) { const float qs = pn < 8 ? C2 : 1.f; if (lat) EpiAct::rope8(v0, v1, row & (NS - 1), wc, fq, rope, qs); else { v0 = v0 * qs; v1 = v1 * qs; } }
                    EpiAct::store8(rowp + bj * 128, v0, v1); } }
    }
};
struct EpiZ {
    static constexpr bool PERM = false, AFTER_DRAIN = false;
    const float* hlat; const float* hctx; float* zlat; float* zctx; const float* mods_l;
    __device__ __forceinline__ void operator()(const pg8::f32x4 (&acc)[2][2][4][2], const pg8::Unit& u, int wr, int wc, int fr, int fq) const {
        const bool lat = u.pm < MLAT / 256; const int bp = lat ? (u.pm >> 3) : 16;
        const int rloc = (lat ? u.pm : u.pm - MLAT / 256) * 256 + wr * 64 + fr, col0 = u.pn * 256 + wc * 32 + 4 * fq;
        const float* hb = lat ? hlat : hctx; float* zb = lat ? zlat : zctx; const float* gp = mods_l + (size_t)bp * 3072 + 2048 + col0;
        pg8::f32x4 g[2][2];
#pragma unroll
        for (int bj = 0; bj < 2; ++bj)
#pragma unroll
            for (int n = 0; n < 2; ++n) g[bj][n] = *(const pg8::f32x4*)(gp + bj * 128 + n * 16);
#pragma unroll
        for (int ai = 0; ai < 2; ++ai)
#pragma unroll
            for (int m = 0; m < 4; ++m) { const size_t off = (size_t)(rloc + ai * 128 + m * 16) * DM + col0;
#pragma unroll
                for (int bj = 0; bj < 2; ++bj)
#pragma unroll
                    for (int n = 0; n < 2; ++n) { const pg8::f32x4 hv = *(const pg8::f32x4*)(hb + off + bj * 128 + n * 16); *(pg8::f32x4*)(zb + off + bj * 128 + n * 16) = hv * ALPHA + g[bj][n] * acc[ai][bj][m][n]; } }
    }
};
struct Order1 {
    pg8::StaticOrder base; int G, c;
    __device__ void init(int G_, int c_) { base.init(MLAT, N1, G_, c_); G = G_; c = c_; }
    __device__ bool next(int i, pg8::Unit& u) const { if (base.next(i, u)) return true; const long L = (long)i * G + c - base.nwg; if (L < 0 || L >= MCTX / 256) return false; u.pm = MLAT / 256 + (int)L; u.pn = 8; return true; }
    __device__ __forceinline__ void a_ready(const pg8::Unit&) const {}
    __device__ __forceinline__ void done(const pg8::Unit&) const {}
};

namespace att {
constexpr int NSLOT = 3, KSLOT = 8192;
constexpr float THR = 8.f;
template <int DV> struct Lay { static constexpr int VSLOT = DV * 128, K_OFF = 0, V_OFF = NSLOT * KSLOT, WS_OFF = V_OFF + NSLOT * VSLOT, ST_OFF = WS_OFF + 8 * 256, ST_WAVE = 64 * DV, END = ST_OFF + 8 * ST_WAVE; };
static_assert(Lay<128>::END <= SCR_BYTES && Lay<64>::END <= SCR_BYTES, "attention LDS layout");
struct KV { const bf16_t* kc; const bf16_t* vc; int nct; const bf16_t* kl; const bf16_t* vl; int nlt; int kb0; };
__device__ __forceinline__ void glds16(const void* gsrc, unsigned lds_dst) { unsigned keep;
    asm volatile("s_mov_b32 %0, m0\n\ts_mov_b32 m0, %2\n\ts_nop 0\n\tglobal_load_lds_dwordx4 %1, off\n\ts_mov_b32 m0, %0" : "=&s"(keep) : "v"(gsrc), "s"(lds_dst) : "memory"); }
__device__ __forceinline__ s16x4 vtr(lds_cptr p) { return __builtin_bit_cast(s16x4, __builtin_amdgcn_ds_read_tr16_b64_v4i16((LAS v4i16_t*)p)); }
#define ATT_WAIT_BAR(N) asm volatile("s_waitcnt vmcnt(" #N ") lgkmcnt(0)\n\ts_barrier" ::: "memory")

template <int DV, int PITCH, bool WIN>
__device__ __forceinline__ void attn_pass(const bf16_t* Qw, const KV kv, const bool has_init, const float m_init, const int qpos0, f32x16 (&o)[DV / 32], float& l_out, char* shm) {
    typedef Lay<DV> LY; constexpr int ND = DV / 32, NVP = DV / 64;
    const int tid = threadIdx.x, lane = tid & 63, r32 = lane & 31, hi = lane >> 5; const int wid = __builtin_amdgcn_readfirstlane(tid >> 6);
    const unsigned lds0 = (unsigned)(uintptr_t)shm; const lds_cptr shm3 = (lds_cptr)shm;
    LAS float* wsf = (LAS float*)(shm3 + LY::WS_OFF) + wid * 64;
    const int NT = kv.nct + kv.nlt;
#define ATT_KBASE(t) ((t) < kv.nct ? kv.kc + (size_t)(t) * 64 * PITCH : kv.kl + (size_t)((t) - kv.nct) * 64 * PITCH)
#define ATT_VBASE(t) ((t) < kv.nct ? kv.vc + (size_t)(t) * 64 * PITCH : kv.vl + (size_t)((t) - kv.nct) * 64 * PITCH)
#define ATT_DMA(t, slot) do { glds16(ATT_KBASE(t) + (size_t)lane * PITCH + wid * 8, (unsigned)__builtin_amdgcn_readfirstlane(lds0 + LY::K_OFF + (slot) * KSLOT + wid * 1024)); \
        _Pragma("unroll") for (int j_ = 0; j_ < NVP; ++j_) { const int pi_ = wid + 8 * j_; \
            glds16(ATT_VBASE(t) + (size_t)(16 * (pi_ & 3) + (lane >> 2)) * PITCH + 32 * (pi_ >> 2) + (lane & 3) * 8, (unsigned)__builtin_amdgcn_readfirstlane(lds0 + LY::V_OFF + (slot) * LY::VSLOT + pi_ * 1024)); } } while (0)
    ATT_DMA(0, 0); if (NT > 1) ATT_DMA(1, 1);
    bf16x8 qr[4];
#pragma unroll
    for (int d0 = 0; d0 < 4; ++d0) qr[d0] = *(const bf16x8*)(Qw + (size_t)r32 * PITCH + d0 * 16 + hi * 8);
    float mhat = has_init ? m_init : 0.f, l_reg = (has_init && hi == 0) ? 1.f : 0.f;
#pragma unroll
    for (int d = 0; d < ND; ++d) o[d] = f32x16{};
    f32x16 negm;
#pragma unroll
    for (int r = 0; r < 16; ++r) negm[r] = -mhat;
    const int qlo = qpos0, qpos = qpos0 + r32;
    const lds_cptr kp0 = shm3 + LY::K_OFF + hi * 1024 + r32 * 16;
    const lds_cptr vp0 = shm3 + LY::V_OFF + ((lane >> 4) & 1) * 32 + (lane & 3) * 8 + (4 * hi + ((lane & 15) >> 2)) * 64;
    int slot = 0, slot2 = 2;
    for (int t = 0; t < NT; ++t) {
        if (t + 1 < NT) { if (NVP == 2) ATT_WAIT_BAR(3); else ATT_WAIT_BAR(2); } else ATT_WAIT_BAR(0);
        if (t + 2 < NT) ATT_DMA(t + 2, slot2);
        bool active = true; int kb = 0;
        if (WIN && t >= kv.nct) { kb = kv.kb0 + (t - kv.nct) * 64; active = !(kb + 63 < qlo - 128 || kb > qlo + 31 + 128); }
        if (active) {
            f32x16 c0, c1; const lds_cptr kp = kp0 + slot * KSLOT;
#pragma unroll
            for (int d0 = 0; d0 < 4; ++d0) {
                const bf16x8 b0 = *(const LAS bf16x8*)(kp + d0 * 2048), b1 = *(const LAS bf16x8*)(kp + d0 * 2048 + 512);
                c0 = __builtin_amdgcn_mfma_f32_32x32x16_bf16(b0, qr[d0], d0 == 0 ? negm : c0, 0, 0, 0);
                c1 = __builtin_amdgcn_mfma_f32_32x32x16_bf16(b1, qr[d0], d0 == 0 ? negm : c1, 0, 0, 0);
            }
            if (WIN && t >= kv.nct) {
#pragma unroll
                for (int r = 0; r < 16; ++r) { const int dlt = kb + crow(r, hi) - qpos; if (dlt > 128 || dlt < -128) c0[r] = -INFINITY; if (dlt + 32 > 128 || dlt + 32 < -128) c1[r] = -INFINITY; }
            }
            float rm = fmaxf(c0[0], c1[0]);
#pragma unroll
            for (int r = 1; r < 16; ++r) rm = fmaxf(rm, fmaxf(c0[r], c1[r]));
            rm = fmaxf(rm, lane32_partner(rm));
            const bool first = (t == 0) && !has_init;
            if (first || __any(rm > THR)) {
                const float dl = first ? rm : fmaxf(rm, 0.f);
                mhat += dl;
#pragma unroll
                for (int r = 0; r < 16; ++r) { c0[r] -= dl; c1[r] -= dl; negm[r] = -mhat; }
                if (!first) {
                    const float f = __builtin_amdgcn_exp2f(-dl); l_reg *= f; if (hi == 0) wsf[r32] = f;
                    asm volatile("s_waitcnt lgkmcnt(0)" ::: "memory");
#pragma unroll
                    for (int g4 = 0; g4 < 4; ++g4) { const f32x4 fv = *(const LAS f32x4*)(wsf + 8 * g4 + 4 * hi);
#pragma unroll
                        for (int d = 0; d < ND; ++d)
#pragma unroll
                            for (int e = 0; e < 4; ++e) o[d][4 * g4 + e] *= fv[e]; }
                }
            }
            float sacc = 0.f;
#pragma unroll
            for (int r = 0; r < 16; ++r) { c0[r] = __builtin_amdgcn_exp2f(c0[r]); c1[r] = __builtin_amdgcn_exp2f(c1[r]); sacc += c0[r] + c1[r]; }
            l_reg += sacc;
            u32x4 pw[4];
#pragma unroll
            for (int e = 0; e < 4; ++e) { pw[0][e] = cvtpk(c0[2 * e], c0[2 * e + 1]); pw[1][e] = cvtpk(c0[8 + 2 * e], c0[9 + 2 * e]); pw[2][e] = cvtpk(c1[2 * e], c1[2 * e + 1]); pw[3][e] = cvtpk(c1[8 + 2 * e], c1[9 + 2 * e]); }
            const lds_cptr vp = vp0 + slot * LY::VSLOT;
#pragma unroll
            for (int d = 0; d < ND; ++d) {
                s16x4 vlo[4], vhi[4];
#pragma unroll
                for (int ks = 0; ks < 4; ++ks) { vlo[ks] = vtr(vp + d * 4096 + ks * 1024); vhi[ks] = vtr(vp + d * 4096 + ks * 1024 + 512); }
#pragma unroll
                for (int ks = 0; ks < 4; ++ks) { const bf16x8 vf = {vlo[ks][0], vlo[ks][1], vlo[ks][2], vlo[ks][3], vhi[ks][0], vhi[ks][1], vhi[ks][2], vhi[ks][3]};
                    o[d] = __builtin_amdgcn_mfma_f32_32x32x16_bf16(__builtin_bit_cast(bf16x8, pw[ks]), vf, o[d], 0, 0, 0); }
            }
        }
        slot = (slot == NSLOT - 1) ? 0 : slot + 1; slot2 = (slot2 == NSLOT - 1) ? 0 : slot2 + 1;
    }
    asm volatile("s_waitcnt lgkmcnt(0)\n\ts_barrier" ::: "memory");
    l_out = l_reg + lane32_partner(l_reg);
#undef ATT_KBASE
#undef ATT_VBASE
#undef ATT_DMA
}
template <int DV> __device__ __forceinline__ void row_recip(float l, float (&rli)[16], char* shm) {
    const int lane = threadIdx.x & 63, r32 = lane & 31, hi = lane >> 5; const int wid = __builtin_amdgcn_readfirstlane(threadIdx.x >> 6);
    LAS float* wsf = (LAS float*)((lds_cptr)shm + Lay<DV>::WS_OFF) + wid * 64;
    if (hi == 0) wsf[32 + r32] = l;
    asm volatile("s_waitcnt lgkmcnt(0)" ::: "memory");
#pragma unroll
    for (int g4 = 0; g4 < 4; ++g4) { const f32x4 lv = *(const LAS f32x4*)(wsf + 32 + 8 * g4 + 4 * hi);
#pragma unroll
        for (int e = 0; e < 4; ++e) rli[4 * g4 + e] = 1.f / lv[e]; }
}
}

__device__ __forceinline__ void diff_unit(const bf16_t* P, int b, int h, int qrow0, bool latq, float lam, const float* subg, bf16_t* mix, char* shm) {
    typedef att::Lay<128> LY;
    const int lane = threadIdx.x & 63, r32 = lane & 31, hi = lane >> 5; const int wid = __builtin_amdgcn_readfirstlane(threadIdx.x >> 6);
    LAS unsigned* park = (LAS unsigned*)((lds_cptr)shm + LY::ST_OFF + wid * LY::ST_WAVE);
    f32x16 o[4]; float l; float rli[16];
    for (int c = 0; c < 2; ++c) {
        att::KV kv; const size_t crow0 = (size_t)(MLAT + b * NC) * N0, lrow0 = (size_t)(b * NS) * N0; const int kcol = 2048 + h * 128 + c * 64, vcol = 2560 + h * 128;
        kv.kc = P + crow0 + kcol; kv.vc = P + crow0 + vcol; kv.nct = NC / 64; kv.kl = P + lrow0 + kcol; kv.vl = P + lrow0 + vcol; kv.nlt = latq ? NS / 64 : 0; kv.kb0 = 0;
        att::attn_pass<128, N0, false>(P + (size_t)(qrow0 + 32 * wid) * N0 + 1536 + h * 128 + c * 64, kv, false, 0.f, 0, o, l, shm);
        att::row_recip<128>(l, rli, shm);
        if (c == 0) {
#pragma unroll
            for (int d = 0; d < 4; ++d)
#pragma unroll
                for (int j = 0; j < 8; ++j) park[(d * 8 + j) * 64 + lane] = cvtpk(o[d][2 * j] * rli[2 * j], o[d][2 * j + 1] * rli[2 * j + 1]);
        }
    }
    asm volatile("s_waitcnt lgkmcnt(0)" ::: "memory");
    float ssq[16];
#pragma unroll
    for (int r = 0; r < 16; ++r) ssq[r] = 0.f;
#pragma unroll
    for (int d = 0; d < 4; ++d)
#pragma unroll
        for (int j = 0; j < 8; ++j) { const unsigned w = park[(d * 8 + j) * 64 + lane];
            const float a0 = bflo(w) - lam * (o[d][2 * j] * rli[2 * j]), a1 = bfhi(w) - lam * (o[d][2 * j + 1] * rli[2 * j + 1]);
            o[d][2 * j] = a0; o[d][2 * j + 1] = a1; ssq[2 * j] += a0 * a0; ssq[2 * j + 1] += a1 * a1; }
#pragma unroll
    for (int r = 0; r < 16; ++r) {
#pragma unroll
        for (int s = 1; s < 32; s <<= 1) ssq[r] += __shfl_xor(ssq[r], s);
        ssq[r] = 1.f / sqrtf(ssq[r] * (1.f / 128.f) + RMS_EPS);
    }
    LAS bf16_t* st = (LAS bf16_t*)park;
#pragma unroll
    for (int r = 0; r < 16; ++r)
#pragma unroll
        for (int d = 0; d < 4; ++d) st[crow(r, hi) * 128 + d * 32 + r32] = (bf16_t)f2bf(o[d][r] * ssq[r]);
    asm volatile("s_waitcnt lgkmcnt(0)" ::: "memory");
    const int ch = lane & 15; float gv[8];
#pragma unroll
    for (int e = 0; e < 8; ++e) gv[e] = subg[8 * ch + e] * (1.f - LAM_INIT0);
#pragma unroll
    for (int i = 0; i < 8; ++i) { const int row = i * 4 + (lane >> 4); const size_t grow = (size_t)(qrow0 + 32 * wid + row);
        const u32x4 v = *(const LAS u32x4*)(st + row * 128 + ch * 8); const u32x4 g = *(const u32x4*)(P + grow * N0 + 3072 + h * 128 + 8 * ch); u32x4 w;
#pragma unroll
        for (int e = 0; e < 4; ++e) w[e] = cvtpk(bflo(v[e]) * gv[2 * e] * bflo(g[e]), bfhi(v[e]) * gv[2 * e + 1] * bfhi(g[e]));
        *(u32x4*)(mix + grow * DM + 512 + h * 128 + 8 * ch) = w; }
    asm volatile("s_waitcnt lgkmcnt(0)" ::: "memory");
}
__device__ __forceinline__ void win_unit(const bf16_t* P, int b, int h, int qb, const float* sink, bf16_t* mix, char* shm) {
    typedef att::Lay<64> LY;
    const int lane = threadIdx.x & 63, r32 = lane & 31, hi = lane >> 5; const int wid = __builtin_amdgcn_readfirstlane(threadIdx.x >> 6);
    const int kvh = h >> 2, lt0 = 4 * qb - 2 < 0 ? 0 : 4 * qb - 2, lt1 = 4 * qb + 6 > NS / 64 ? NS / 64 : 4 * qb + 6;
    att::KV kv; const size_t crow0 = (size_t)(MLAT + b * NC) * P1W, lrow0 = (size_t)(b * NS + lt0 * 64) * P1W;
    kv.kc = P + crow0 + 1536 + kvh * 64; kv.vc = P + crow0 + 1664 + kvh * 64; kv.nct = NC / 64; kv.kl = P + lrow0 + 1536 + kvh * 64; kv.vl = P + lrow0 + 1664 + kvh * 64; kv.nlt = lt1 - lt0; kv.kb0 = lt0 * 64;
    const int qrow0 = b * NS + qb * 256;
    f32x16 o[2]; float l; float rli[16];
    att::attn_pass<64, P1W, true>(P + (size_t)(qrow0 + 32 * wid) * P1W + 1024 + h * 64, kv, true, sink[h] * LOG2E, qb * 256 + 32 * wid, o, l, shm);
    att::row_recip<64>(l, rli, shm);
    LAS bf16_t* st = (LAS bf16_t*)((lds_cptr)shm + LY::ST_OFF + wid * LY::ST_WAVE);
#pragma unroll
    for (int r = 0; r < 16; ++r)
#pragma unroll
        for (int d = 0; d < 2; ++d) st[crow(r, hi) * 64 + d * 32 + r32] = (bf16_t)f2bf(o[d][r] * rli[r]);
    asm volatile("s_waitcnt lgkmcnt(0)" ::: "memory");
    const int ch = lane & 7;
#pragma unroll
    for (int i = 0; i < 4; ++i) { const int row = i * 8 + (lane >> 3); const size_t grow = (size_t)(qrow0 + 32 * wid + row);
        const u32x4 v = *(const LAS u32x4*)(st + row * 64 + ch * 8); const u32x4 g = *(const u32x4*)(P + grow * P1W + 1792 + h * 64 + 8 * ch); u32x4 w;
#pragma unroll
        for (int e = 0; e < 4; ++e) w[e] = cvtpk(bflo(v[e]) * bflo(g[e]), bfhi(v[e]) * bfhi(g[e]));
        *(u32x4*)(mix + grow * DM + 512 + h * 64 + 8 * ch) = w; }
    asm volatile("s_waitcnt lgkmcnt(0)" ::: "memory");
}

__device__ __forceinline__ void gmlp_unit(const bf16_t* P, int ci, const bf16_t* wsb, const float* a_b_s, const float* ng, const float* nb, bf16_t* mix, char* shm) {
    const int tid = threadIdx.x, lane = tid & 63, r32 = lane & 31, hi = lane >> 5; const int wave = __builtin_amdgcn_readfirstlane(tid >> 6);
    const int row0 = 128 * ci; const lds_cptr shm3 = (lds_cptr)shm;
    __syncthreads();
    {
        float gg[8], bb[8];
#pragma unroll
        for (int e = 0; e < 8; ++e) { gg[e] = ng[8 * lane + e]; bb[e] = nb[8 * lane + e]; }
#pragma unroll 4
        for (int j = 0; j < 16; ++j) { const int q = 16 * wave + j;
            const bf16x8 v = *(const bf16x8*)(P + (size_t)(row0 + q) * N0 + 512 + 8 * lane);
            float f[8], s = 0.f;
#pragma unroll
            for (int e = 0; e < 8; ++e) { f[e] = bf2f((bf16_t)v[e]); s += f[e]; }
            const float mean = wave_sum(s) * (1.f / 512.f); float s2 = 0.f;
#pragma unroll
            for (int e = 0; e < 8; ++e) { f[e] -= mean; s2 += f[e] * f[e]; }
            const float rstd = 1.f / sqrtf(wave_sum(s2) * (1.f / 512.f) + LN_EPS);
            u32x4 w;
#pragma unroll
            for (int e = 0; e < 4; ++e) w[e] = cvtpk(f[2 * e] * rstd * gg[2 * e] + bb[2 * e], f[2 * e + 1] * rstd * gg[2 * e + 1] + bb[2 * e + 1]);
            *(LAS u32x4*)(shm3 + ((lane >> 2) * 8 + wave) * 1024 + j * 64 + (lane & 3) * 16) = w; }
    }
    __syncthreads();
    const int pw = wave & 3, dh = wave >> 2;
    const lds_cptr vpl = shm3 + ((lane >> 4) & 1) * 32 + (lane & 3) * 8 + (4 * hi + ((lane & 15) >> 2)) * 64;
    for (int g = 0; g < 4; ++g) {
        f32x16 acc[2]; acc[0] = f32x16{}; acc[1] = f32x16{};
        const bf16_t* wrow = wsb + ((size_t)(g * 128 + 32 * pw + r32)) * 128 + 4 * hi;
#pragma unroll
        for (int s = 0; s < 8; ++s) {
            const u32x2 alo = *(const u32x2*)(wrow + 16 * s), ahi = *(const u32x2*)(wrow + 16 * s + 8);
            const u32x4 af = {alo[0], alo[1], ahi[0], ahi[1]};
#pragma unroll
            for (int nt = 0; nt < 2; ++nt) { const int db = 4 * g + 2 * dh + nt; const lds_cptr bp = vpl + (db * 8 + s) * 1024;
                const s16x4 lo = att::vtr(bp), hh = att::vtr(bp + 512);
                const bf16x8 vf = {lo[0], lo[1], lo[2], lo[3], hh[0], hh[1], hh[2], hh[3]};
                acc[nt] = __builtin_amdgcn_mfma_f32_32x32x16_bf16(__builtin_bit_cast(bf16x8, af), vf, acc[nt], 0, 0, 0); }
        }
#pragma unroll
        for (int nt = 0; nt < 2; ++nt)
#pragma unroll
            for (int r = 0; r < 16; ++r) { const int p = 32 * pw + crow(r, hi), col = 128 * g + 64 * dh + 32 * nt + r32; const size_t grow = (size_t)(row0 + p);
                const float val = acc[nt][r] + a_b_s[g * 128 + p];
                mix[grow * DM + col] = (bf16_t)f2bf(bf2f(P[grow * N0 + col]) * val * bf2f(P[grow * N0 + 1024 + col])); }
    }
    __syncthreads();
}

__device__ __forceinline__ void conv_unit(const bf16_t* P, int b, int tt, const float* dw_w, const float* dw_b, const float* cn_g, const float* cn_b, bf16_t* mix, char* shm) {
    const int tid = threadIdx.x, lane = tid & 63; const int wave = __builtin_amdgcn_readfirstlane(tid >> 6);
    const lds_cptr hs = (lds_cptr)shm; LAS float* ys = (LAS float*)((lds_cptr)shm + 65536);
    const int t0 = 32 * tt; const size_t R0 = (size_t)b * NS + t0;
    __syncthreads();
    for (int i = tid; i < 62 * 64; i += 512) { const int r = i >> 6, ch = i & 63, t = t0 - 15 + r; u32x4 v = {0u, 0u, 0u, 0u};
        if (t >= 0 && t < NS) v = *(const u32x4*)(P + (R0 + r - 15) * P1W + ch * 8);
        *(LAS u32x4*)(hs + r * 1024 + ch * 16) = v; }
    __syncthreads();
    {
        const int cp = tid & 255, th = tid >> 8;
        float w0[31], w1[31];
#pragma unroll
        for (int k = 0; k < 31; ++k) { const f32x2_t w = *(const f32x2_t*)(dw_w + k * 512 + 2 * cp); w0[k] = w[0]; w1[k] = w[1]; }
        const f32x2_t bias = *(const f32x2_t*)(dw_b + 2 * cp);
        float a0[16], a1[16];
#pragma unroll
        for (int j = 0; j < 16; ++j) { a0[j] = bias[0]; a1[j] = bias[1]; }
#pragma unroll
        for (int i = 0; i < 46; ++i) { const unsigned hv = *(const LAS unsigned*)(hs + (16 * th + i) * 1024 + cp * 4); const float x0 = bflo(hv), x1 = bfhi(hv);
#pragma unroll
            for (int j = 0; j < 16; ++j) { const int k = i - j; if (k >= 0 && k < 31) { a0[j] += w0[k] * x0; a1[j] += w1[k] * x1; } } }
#pragma unroll
        for (int j = 0; j < 16; ++j) { f32x2_t y = {a0[j], a1[j]}; *(LAS f32x2_t*)(ys + (16 * th + j) * 512 + 2 * cp) = y; }
    }
    __syncthreads();
    {
        float gg[8], bb[8];
#pragma unroll
        for (int e = 0; e < 8; ++e) { gg[e] = cn_g[8 * lane + e]; bb[e] = cn_b[8 * lane + e]; }
#pragma unroll
        for (int j = 0; j < 4; ++j) { const int tok = 4 * wave + j; const size_t grow = R0 + tok;
            const f32x4 y0 = *(const LAS f32x4*)(ys + tok * 512 + 8 * lane), y1 = *(const LAS f32x4*)(ys + tok * 512 + 8 * lane + 4);
            float f[8] = {y0[0], y0[1], y0[2], y0[3], y1[0], y1[1], y1[2], y1[3]}; float s = 0.f;
#pragma unroll
            for (int e = 0; e < 8; ++e) s += f[e];
            const float mean = wave_sum(s) * (1.f / 512.f); float s2 = 0.f;
#pragma unroll
            for (int e = 0; e < 8; ++e) { f[e] -= mean; s2 += f[e] * f[e]; }
            const float rstd = 1.f / sqrtf(wave_sum(s2) * (1.f / 512.f) + LN_EPS);
            const u32x4 cg = *(const u32x4*)(P + grow * P1W + 512 + 8 * lane); u32x4 w;
#pragma unroll
            for (int e = 0; e < 4; ++e) { const float ya = silu_f(f[2 * e] * rstd * gg[2 * e] + bb[2 * e]), yb = silu_f(f[2 * e + 1] * rstd * gg[2 * e + 1] + bb[2 * e + 1]);
                w[e] = cvtpk(ya * bflo(cg[e]), yb * bfhi(cg[e])); }
            *(u32x4*)(mix + grow * DM + 8 * lane) = w; }
    }
    __syncthreads();
}

__device__ __forceinline__ void p0_transpose_item(const float* W, int N, int nsrc0, bf16_t* WT, int n0, int k0, LAS float* scr, int lane) {
#pragma unroll 8
    for (int i = 0; i < 32; ++i) { const int kk = 2 * i + (lane >> 5); scr[kk * 33 + (lane & 31)] = W[(size_t)(k0 + kk) * N + nsrc0 + (lane & 31)]; }
    LDS_WAIT(); asm volatile("" ::: "memory");
    const int c = lane & 7;
#pragma unroll
    for (int j = 0; j < 4; ++j) { const int n = (lane >> 3) + 8 * j; const LAS float* s = scr + (8 * c) * 33 + n;
        u32x4 o; o.x = pk2(s[0 * 33], s[1 * 33]); o.y = pk2(s[2 * 33], s[3 * 33]); o.z = pk2(s[4 * 33], s[5 * 33]); o.w = pk2(s[6 * 33], s[7 * 33]);
        *(u32x4*)(WT + (size_t)(n0 + n) * 1024 + k0 + 8 * c) = o; }
    LDS_WAIT(); asm volatile("" ::: "memory");
}

struct Args { const float* in[26]; float* out; unsigned char* ws; int ph_lo, ph_hi, li, pad; };
__global__ void __launch_bounds__(512, 2) mega_fwd(Args args) {
    extern __shared__ __attribute__((aligned(16))) unsigned char lds[];
    const ldsp_t L = (ldsp_t)lds; char* const shm = (char*)lds;
    volatile LAS unsigned* MISC = (volatile LAS unsigned*)(L + MISC_OFF);
    LAS float* rope = (LAS float*)(L + ROPE_OFF);
    const int tid = threadIdx.x, lane = tid & 63; const int wave = __builtin_amdgcn_readfirstlane(tid >> 6);
    const int G = gridDim.x; const int vcu = (G % 8 == 0) ? (blockIdx.x % 8) * (G / 8) + blockIdx.x / 8 : blockIdx.x;
    const int gw = vcu * 8 + wave, NGW = G * 8;
    unsigned char* ws = args.ws; float* out = args.out;
    const float* x = args.in[0]; const float* cvec = args.in[1]; const float* ctx = args.in[2]; const float* c_ctx = args.in[3];
    const float* mod_w = args.in[4]; const float* mod_b = args.in[5]; const float* ln_g = args.in[6]; const float* ln_b = args.in[7];
    float* mods = (float*)(ws + WS_MODS); bf16_t* wsb = (bf16_t*)(ws + WS_WSB);
    bf16_t* W0t = (bf16_t*)(ws + WS_W0T); bf16_t* Wo0t = (bf16_t*)(ws + WS_WO0T); bf16_t* W1t = (bf16_t*)(ws + WS_W1T); bf16_t* Wo1t = (bf16_t*)(ws + WS_WO1T);
    float* zc = (float*)(ws + WS_ZC); bf16_t* bufA = (bf16_t*)(ws + WS_A); bf16_t* bufB = (bf16_t*)(ws + WS_B);
    if (tid < 64) ((LAS unsigned*)(L + MISC_OFF))[tid] = 0u;
    for (int idx = tid; idx < 1024; idx += 512) { const int pos = idx >> 4, j = idx & 15; const float ang = (float)pos * powf(10000.f, -(float)j / 16.f); rope[idx] = cosf(ang); rope[1024 + idx] = sinf(ang); }
    __syncthreads();
    XcdBarrier bar = xcd_barrier_post((unsigned*)(ws + WS_CTL) + CW_BAR + args.li * XCD_BAR_WORDS, MISC + 8);
    const int lo = args.ph_lo, hi = args.ph_hi;
#define IN(k) (lo <= (k) && (k) < hi)
#define SEAM(k) do { if (IN(k) && IN((k) + 1)) xcd_barrier(bar); } while (0)

    if (IN(0)) {
        if (blockIdx.x < 192) {
            const int l = blockIdx.x / 96, c0 = (blockIdx.x % 96) * 32;
            LAS float* st = (LAS float*)L; LAS float* red = st + 17 * 1024;
            for (int i = tid; i < 17 * 1024; i += 512) { const int bp = i >> 10, k = i & 1023; st[i] = silu_f(bp < 16 ? cvec[bp * 1024 + k] : c_ctx[k]); }
            __syncthreads();
            const int kr = lane >> 5, col = lane & 31;
            float acc[17];
#pragma unroll
            for (int bp = 0; bp < 17; ++bp) acc[bp] = 0.f;
            const float* wp = mod_w + ((size_t)l * 1024 + 128 * wave + kr) * 3072 + c0 + col;
#pragma unroll 8
            for (int i = 0; i < 64; ++i) { const float wv = wp[(size_t)i * 2 * 3072]; const int k = 128 * wave + 2 * i + kr;
#pragma unroll
                for (int bp = 0; bp < 17; ++bp) acc[bp] += st[bp * 1024 + k] * wv; }
#pragma unroll
            for (int bp = 0; bp < 17; ++bp) { acc[bp] += __shfl_xor(acc[bp], 32); if (kr == 0) red[(wave * 17 + bp) * 32 + col] = acc[bp]; }
            __syncthreads();
            for (int i = tid; i < 17 * 32; i += 512) { const int bp = i >> 5, cc = i & 31; float s = 0.f;
#pragma unroll
                for (int w = 0; w < 8; ++w) s += red[(w * 17 + bp) * 32 + cc];
                mods[(size_t)(l * 17 + bp) * 3072 + c0 + cc] = s + mod_b[l * 3072 + c0 + cc]; }
            __syncthreads();
        } else {
            const float* a_w_s = args.in[10]; const int i = (blockIdx.x - 192) * 512 + tid;
            if (i < 32768) { wsb[i] = (bf16_t)f2bf(a_w_s[i]); wsb[i + 32768] = (bf16_t)f2bf(a_w_s[i + 32768]); }
        }
        LAS float* scr = (LAS float*)(L + wave * 16384);
        constexpr int I0 = 16 * (N0 / 32), IO = 16 * 32, I1 = 16 * (N1 / 32), NITEMS = I0 + IO + I1 + IO;
        for (int it = gw; it < NITEMS; it += NGW) {
            int r = it;
            if (r < I0) { const int kb = r / (N0 / 32), nb = r % (N0 / 32); p0_transpose_item(args.in[8], N0, 32 * nb, W0t, 32 * nb, 64 * kb, scr, lane); continue; } r -= I0;
            if (r < IO) { const int kb = r / 32, nb = r % 32; p0_transpose_item(args.in[9], 1024, 32 * nb, Wo0t, 32 * nb, 64 * kb, scr, lane); continue; } r -= IO;
            if (r < I1) { const int kb = r / (N1 / 32), nb = r % (N1 / 32); p0_transpose_item(args.in[19], N1, w_src_col<1>(32 * nb), W1t, 32 * nb, 64 * kb, scr, lane); continue; } r -= I1;
            { const int kb = r / 32, nb = r % 32; p0_transpose_item(args.in[20], 1024, 32 * nb, Wo1t, 32 * nb, 64 * kb, scr, lane); }
        }
    }
    SEAM(0);
    if (IN(1)) {
        for (int row = gw; row < MTOT; row += NGW) { const int bp = row < MLAT ? row / NS : 16; const float* in = row < MLAT ? x + (size_t)row * DM : ctx + (size_t)(row - MLAT) * DM;
            const float* md = mods + (size_t)bp * 3072; row_op<0>(in, nullptr, bufA + (size_t)row * DM, nullptr, nullptr, md, md + 1024, lane); }
    }
    SEAM(1);
    if (IN(2)) {
        pg8::Gemm g{bufA, W0t, MTOT, N0, DM}; pg8::StaticOrder S; S.init(MTOT, N0, G, (int)blockIdx.x);
        Epi0 E{bufB, rope};
        pg8::gemm_phase<Epi0, pg8::StaticOrder, true, true>(L, g, S, E);
    }
    SEAM(2);
    if (IN(3)) {
        const float* lq1 = args.in[14]; const float* lk1 = args.in[15]; const float* lq2 = args.in[16]; const float* lk2 = args.in[17];
        const float lam = __expf(wave_sum(lq1[lane] * lk1[lane])) - __expf(wave_sum(lq2[lane] * lk2[lane])) + LAM_INIT0;
        for (int u = vcu; u < 512; u += G) { const int bh = u >> 3, qb = u & 7; diff_unit(bufB, bh >> 2, bh & 3, (bh >> 2) * NS + qb * 256, true, lam, args.in[18], bufA, shm); }
        for (int s = vcu; s < 352; s += G) {
            if (s < 288) gmlp_unit(bufB, s, wsb, args.in[11], args.in[12], args.in[13], bufA, shm);
            else { const int bh = s - 288; diff_unit(bufB, bh >> 2, bh & 3, MLAT + (bh >> 2) * NC, false, lam, args.in[18], bufA, shm); }
        }
    }
    SEAM(3);
    if (IN(4)) {
        pg8::Gemm g{bufA, Wo0t, MTOT, DM, DM}; pg8::StaticOrder S; S.init(MTOT, DM, G, (int)blockIdx.x);
        EpiZ E{x, ctx, out, zc, mods};
        pg8::gemm_phase<EpiZ, pg8::StaticOrder, true, true>(L, g, S, E);
    }
    SEAM(4);
    if (IN(5)) {
        for (int row = gw; row < MTOT; row += NGW) { const int bp = row < MLAT ? row / NS : 16; const float* md = mods + (size_t)(17 + bp) * 3072;
            if (row < MLAT) row_op<1>(out + (size_t)row * DM, out + (size_t)row * DM, bufA + (size_t)row * DM, ln_g, ln_b, md, md + 1024, lane);
            else row_op<1>(zc + (size_t)(row - MLAT) * DM, nullptr, bufA + (size_t)row * DM, ln_g, ln_b, md, md + 1024, lane); }
    }
    SEAM(5);
    if (IN(6)) {
        pg8::Gemm g{bufA, W1t, MTOT, N1, DM}; Order1 S; S.init(G, (int)blockIdx.x);
        Epi1 E{bufB, rope};
        pg8::gemm_phase<Epi1, Order1, true, true>(L, g, S, E);
    }
    SEAM(6);
    if (IN(7)) {
        for (int u = vcu; u < 1024; u += G) { const int bh = u >> 3; win_unit(bufB, bh >> 3, bh & 7, u & 7, args.in[25], bufA, shm); }
        for (int u = vcu; u < 1024; u += G) conv_unit(bufB, u >> 6, u & 63, args.in[21], args.in[22], args.in[23], args.in[24], bufA, shm);
    }
    SEAM(7);
    if (IN(8)) {
        pg8::Gemm g{bufA, Wo1t, MLAT, DM, DM}; pg8::StaticOrder S; S.init(MLAT, DM, G, (int)blockIdx.x);
        EpiZ E{out, nullptr, out, nullptr, mods + 17 * 3072};
        pg8::gemm_phase<EpiZ, pg8::StaticOrder, true, true>(L, g, S, E);
    }
    SEAM(8);
    if (IN(9)) {
        for (int row = gw; row < MLAT; row += NGW) row_op<2>(out + (size_t)row * DM, out + (size_t)row * DM, nullptr, ln_g + 1024, ln_b + 1024, nullptr, nullptr, lane);
    }
#undef IN
#undef SEAM
}

#ifndef FASTMASK
#define FASTMASK 0x3ff
#endif
extern "C" void kernel_launch(void* const* d_in, const int* in_sizes, int n_in, void* d_out, int out_size, void* d_ws, size_t ws_size, hipStream_t stream) {
    static int ready = 0;
    if (ready == 0) {
        if (n_in != 26 || out_size != MLAT * DM || ws_size < WS_END) { fprintf(stderr, "kernel_launch: unexpected shapes (n_in %d out %d ws %zu)\n", n_in, out_size, ws_size); ready = -1; return; }
        int dev = 0, cus = 0;
        if (hipGetDevice(&dev) != hipSuccess || hipDeviceGetAttribute(&cus, hipDeviceAttributeMultiprocessorCount, dev) != hipSuccess || cus < 256) { fprintf(stderr, "kernel_launch: needs a 256-CU device (got %d)\n", cus); ready = -1; return; }
        if (hipFuncSetAttribute((const void*)mega_fwd, hipFuncAttributeMaxDynamicSharedMemorySize, LDS_BYTES) != hipSuccess) { fprintf(stderr, "kernel_launch: hipFuncSetAttribute failed\n"); ready = -1; return; }
        int per_cu = 0;
        if (hipOccupancyMaxActiveBlocksPerMultiprocessor(&per_cu, (const void*)mega_fwd, 512, LDS_BYTES) != hipSuccess || per_cu < 1) fprintf(stderr, "kernel_launch: note: occupancy query reports %d blocks per CU\n", per_cu);
        (void)hipGetLastError();
        ready = 1;
    }
    if (ready < 0) return;
    unsigned char* ws = (unsigned char*)d_ws; float* out = (float*)d_out;
    (void)hipMemsetAsync(ws + WS_CTL, 0, 1 * MiB, stream);
    Args a{};
    for (int i = 0; i < 26; ++i) a.in[i] = (const float*)d_in[i];
    a.out = out; a.ws = ws;
#if FASTMASK == 0x3ff
    a.ph_lo = 0; a.ph_hi = 10; a.li = 0;
    hipLaunchKernelGGL(mega_fwd, dim3(256), dim3(512), LDS_BYTES, stream, a);
#else
    const float* x = (const float*)d_in[0]; const float* c = (const float*)d_in[1]; const float* ctx = (const float*)d_in[2]; const float* c_ctx = (const float*)d_in[3];
    const float* mod_w = (const float*)d_in[4]; const float* mod_b = (const float*)d_in[5]; const float* ln_g = (const float*)d_in[6]; const float* ln_b = (const float*)d_in[7];
    const float* ab_w_in = (const float*)d_in[8]; const float* ab_w_out = (const float*)d_in[9]; const float* a_w_s = (const float*)d_in[10]; const float* a_b_s = (const float*)d_in[11];
    const float* a_norm_g = (const float*)d_in[12]; const float* a_norm_b = (const float*)d_in[13];
    const float* lq1 = (const float*)d_in[14]; const float* lk1 = (const float*)d_in[15]; const float* lq2 = (const float*)d_in[16]; const float* lk2 = (const float*)d_in[17];
    const float* subg = (const float*)d_in[18]; const float* cd_w_in = (const float*)d_in[19]; const float* cd_w_out = (const float*)d_in[20];
    const float* dw_w = (const float*)d_in[21]; const float* dw_b = (const float*)d_in[22]; const float* cn_g = (const float*)d_in[23]; const float* cn_b = (const float*)d_in[24];
    const float* sink = (const float*)d_in[25];
    float* mods = (float*)(ws + WS_MODS); float* rope = (float*)(ws + WS_ROPE); bf16_t* wsb = (bf16_t*)(ws + WS_WSB); float* stats = (float*)(ws + WS_STATS);
    bf16_t* W0t = (bf16_t*)(ws + WS_W0T); bf16_t* Wo0t = (bf16_t*)(ws + WS_WO0T); bf16_t* W1t = (bf16_t*)(ws + WS_W1T); bf16_t* Wo1t = (bf16_t*)(ws + WS_WO1T);
    float* zc = (float*)(ws + WS_ZC); bf16_t* bufA = (bf16_t*)(ws + WS_A); bf16_t* bufB = (bf16_t*)(ws + WS_B); float* tmp = (float*)(ws + WS_T);
    int li = 0;
    k_misc<<<(4 * 128 * 128 + 255) / 256, 256, 0, stream>>>(a_w_s, wsb, rope);
    for (int p = 0; p < 10; ++p) {
        if ((FASTMASK >> p) & 1) { int q = p; while (q < 10 && ((FASTMASK >> q) & 1)) ++q; a.ph_lo = p; a.ph_hi = q; a.li = li++; hipLaunchKernelGGL(mega_fwd, dim3(256), dim3(512), LDS_BYTES, stream, a); p = q - 1; continue; }
        switch (p) {
        case 0:
            k_transpose<0><<<dim3(32, N0 / 32), 256, 0, stream>>>(ab_w_in, N0, W0t); k_transpose<0><<<dim3(32, 32), 256, 0, stream>>>(ab_w_out, 1024, Wo0t);
            k_transpose<1><<<dim3(32, N1 / 32), 256, 0, stream>>>(cd_w_in, N1, W1t); k_transpose<0><<<dim3(32, 32), 256, 0, stream>>>(cd_w_out, 1024, Wo1t);
            k_mods<<<(2 * 17 * 3072 + 255) / 256, 256, 0, stream>>>(c, c_ctx, mod_w, mod_b, mods); break;
        case 1: k_p1<<<MTOT / 4, 256, 0, stream>>>(x, ctx, mods, bufA); break;
        case 2: k_gemm_in0<<<dim3(N0 / 128, MTOT / 32), 256, 0, stream>>>(bufA, W0t, bufB, rope); break;
        case 3:
            k_diffattn<<<(MTOT * 8) / 256, 256, 0, stream>>>(bufB, tmp); k_diffcombine<<<(MTOT * 4) / 4, 256, 0, stream>>>(tmp, bufB, lq1, lk1, lq2, lk2, subg, bufA);
            k_gmlp_stats<<<MTOT / 4, 256, 0, stream>>>(bufB, stats); k_gmlp<<<(MTOT * 512) / 256, 256, 0, stream>>>(bufB, stats, a_w_s, a_b_s, a_norm_g, a_norm_b, bufA); break;
        case 4: k_gemm_out<<<dim3(1024 / 128, MTOT / 32), 256, 0, stream>>>(bufA, Wo0t, x, ctx, mods, out, zc); break;
        case 5: k_p5<<<MTOT / 4, 256, 0, stream>>>(out, zc, mods, ln_g, ln_b, bufA); break;
        case 6: k_gemm_in1<<<dim3(N1 / 128, MTOT / 32), 256, 0, stream>>>(bufA, W1t, bufB, rope); break;
        case 7:
            k_winattn<<<(MLAT * 8) / 256, 256, 0, stream>>>(bufB, sink, bufA); k_conv<<<(MLAT * 512) / 256, 256, 0, stream>>>(bufB, dw_w, dw_b, tmp);
            k_conv_ln<<<MLAT / 4, 256, 0, stream>>>(tmp, bufB, cn_g, cn_b, bufA); break;
        case 8: k_gemm_out<<<dim3(1024 / 128, MLAT / 32), 256, 0, stream>>>(bufA, Wo1t, out, nullptr, mods + 17 * 3072, out, nullptr); break;
        case 9: k_p9<<<MLAT / 4, 256, 0, stream>>>(out, ln_g, ln_b); break;
        }
    }
#endif
}
```
